# Optimizing an MI355X kernel written in HIP

```python
import math
import jax, jax.numpy as jnp
from jax import lax
import numpy as np

D_MODEL = 1024
BATCH = 16
SEQ = 2048
DEPTH = 4

CHUNK = 64
N_MIXERS = 2
N_HEADS_A = 16
HEAD_DIM_A = D_MODEL // N_HEADS_A
LEFT_CHUNKS = 8
BAND = (LEFT_CHUNKS + 1) * CHUNK
REL_CLIP = 128
N_HEADS_B = 16
HEAD_DIM_B = D_MODEL // N_HEADS_B
SB_BLOCK = 128
D_FF = 2816
ALPHA = (2.0 * DEPTH) ** 0.25
BETA = (8.0 * DEPTH) ** -0.25
LN_EPS = 1e-5
N_A_LAYERS = (DEPTH + N_MIXERS - 1) // N_MIXERS
N_B_LAYERS = DEPTH // N_MIXERS

kernel_name = "hybrid_chunked_relbias_stickbreaking_macaron_deepnorm"


def layer_norm(x, g, b):
    xf = x.astype(jnp.float32)
    mu = jnp.mean(xf, axis=-1, keepdims=True)
    var = jnp.mean(jnp.square(xf - mu), axis=-1, keepdims=True)
    y = (xf - mu) * lax.rsqrt(var + LN_EPS)
    return (y * g.astype(jnp.float32) + b.astype(jnp.float32)).astype(x.dtype)


def swiglu(x, w_gate, w_up, w_down):
    return (jax.nn.silu(x @ w_gate) * (x @ w_up)) @ w_down


def rel_bias_band(rel_table):
    i = np.arange(CHUNK)[:, None]
    j = np.arange(BAND)[None, :]
    rel = (np.clip(i - j + LEFT_CHUNKS * CHUNK, -REL_CLIP, REL_CLIP) + REL_CLIP).astype(np.int32)
    return jnp.transpose(rel_table[rel], (2, 0, 1))


def chunked_rel_attention(x, w_qkv, w_o, rel_table):
    B, S, _ = x.shape
    n_chunks = S // CHUNK
    qkv = (x @ w_qkv).reshape(B, S, 3, N_HEADS_A, HEAD_DIM_A)
    q, k, v = qkv[:, :, 0], qkv[:, :, 1], qkv[:, :, 2]
    pad = LEFT_CHUNKS * CHUNK
    k_pad = jnp.pad(k, ((0, 0), (pad, 0), (0, 0), (0, 0)))
    v_pad = jnp.pad(v, ((0, 0), (pad, 0), (0, 0), (0, 0)))
    bias = rel_bias_band(rel_table).astype(jnp.float32)
    key_offset = jnp.arange(BAND) - pad
    scale = HEAD_DIM_A ** -0.5

    def one_chunk(c):
        start = c * CHUNK
        q_c = lax.dynamic_slice_in_dim(q, start, CHUNK, axis=1)
        k_c = lax.dynamic_slice_in_dim(k_pad, start, BAND, axis=1)
        v_c = lax.dynamic_slice_in_dim(v_pad, start, BAND, axis=1)
        s = jnp.einsum('bqhd,bkhd->bhqk', q_c, k_c,
                       preferred_element_type=jnp.float32) * scale + bias
        valid = (start + key_offset) >= 0
        s = jnp.where(valid[None, None, None, :], s, -jnp.inf)
        p = jax.nn.softmax(s, axis=-1).astype(v_c.dtype)
        return jnp.einsum('bhqk,bkhd->bqhd', p, v_c)

    out = lax.map(one_chunk, jnp.arange(n_chunks))
    out = jnp.transpose(out, (1, 0, 2, 3, 4)).reshape(B, S, D_MODEL)
    return out @ w_o


def stick_breaking_attention(x, w_qkv, w_o):
    B, S, _ = x.shape
    qkv = (x @ w_qkv).reshape(B, S, 3, N_HEADS_B, HEAD_DIM_B)
    q, k, v = qkv[:, :, 0], qkv[:, :, 1], qkv[:, :, 2]
    scale = HEAD_DIM_B ** -0.5
    outs = []
    for blk in range(S // SB_BLOCK):
        q0 = blk * SB_BLOCK
        kv_len = q0 + SB_BLOCK
        q_b = q[:, q0:kv_len]
        k_b = k[:, :kv_len]
        v_b = v[:, :kv_len]
        z = jnp.einsum('bqhd,bkhd->bhqk', q_b, k_b,
                       preferred_element_type=jnp.float32) * scale
        t_pos = q0 + jnp.arange(SB_BLOCK)[:, None]
        s_pos = jnp.arange(kv_len)[None, :]
        causal = s_pos < t_pos
        log_beta = jnp.where(causal, jax.nn.log_sigmoid(z), -jnp.inf)
        log_1m_beta = jnp.where(causal, jax.nn.log_sigmoid(-z), 0.0)
        stick = lax.cumsum(log_1m_beta, axis=log_1m_beta.ndim - 1, reverse=True) - log_1m_beta
        a = jnp.exp(log_beta + stick).astype(v_b.dtype)
        outs.append(jnp.einsum('bhqk,bkhd->bqhd', a, v_b))
    out = jnp.concatenate(outs, axis=1).reshape(B, S, D_MODEL)
    return out @ w_o


def setup_inputs(seed: int = 0) -> dict:
    key = jax.random.key(seed)
    ks = jax.random.split(key, 16)
    d_sc = D_MODEL ** -0.5
    f_sc = D_FF ** -0.5
    x = jax.random.normal(ks[0], (BATCH, SEQ, D_MODEL), jnp.float32)

    def qkv_weights(k, n):
        kq, kk, kv = jax.random.split(k, 3)
        wq = jax.random.normal(kq, (n, D_MODEL, D_MODEL), jnp.float32) * d_sc
        wk = jax.random.normal(kk, (n, D_MODEL, D_MODEL), jnp.float32) * d_sc
        wv = jax.random.normal(kv, (n, D_MODEL, D_MODEL), jnp.float32) * (d_sc * BETA)
        return jnp.concatenate([wq, wk, wv], axis=-1)

    w_qkv_a = qkv_weights(ks[1], N_A_LAYERS)
    w_o_a = jax.random.normal(ks[2], (N_A_LAYERS, D_MODEL, D_MODEL), jnp.float32) * (d_sc * BETA)
    rel_bias = jax.random.normal(ks[3], (2 * REL_CLIP + 1, N_HEADS_A), jnp.float32) * 0.5
    w_qkv_b = qkv_weights(ks[4], N_B_LAYERS)
    w_o_b = jax.random.normal(ks[5], (N_B_LAYERS, D_MODEL, D_MODEL), jnp.float32) * (d_sc * BETA)
    ffn_w_gate = jax.random.normal(ks[6], (DEPTH, 2, D_MODEL, D_FF), jnp.float32) * d_sc
    ffn_w_up = jax.random.normal(ks[7], (DEPTH, 2, D_MODEL, D_FF), jnp.float32) * d_sc
    ffn_w_down = jax.random.normal(ks[8], (DEPTH, 2, D_FF, D_MODEL), jnp.float32) * (f_sc * BETA)
    ln_g = 1.0 + 0.02 * jax.random.normal(ks[9], (DEPTH, 3, D_MODEL), jnp.float32)
    ln_b = 0.02 * jax.random.normal(ks[10], (DEPTH, 3, D_MODEL), jnp.float32)
    return {"x": x, "w_qkv_a": w_qkv_a, "w_o_a": w_o_a, "rel_bias": rel_bias,
            "w_qkv_b": w_qkv_b, "w_o_b": w_o_b, "ffn_w_gate": ffn_w_gate,
            "ffn_w_up": ffn_w_up, "ffn_w_down": ffn_w_down, "ln_g": ln_g, "ln_b": ln_b}


def reference(x, w_qkv_a, w_o_a, rel_bias, w_qkv_b, w_o_b, ffn_w_gate, ffn_w_up,
              ffn_w_down, ln_g, ln_b):
    for i in range(DEPTH):
        h = swiglu(x, ffn_w_gate[i, 0], ffn_w_up[i, 0], ffn_w_down[i, 0])
        x = layer_norm(ALPHA * x + 0.5 * h, ln_g[i, 0], ln_b[i, 0])
        j = i // N_MIXERS
        if i % N_MIXERS == 0:
            y = chunked_rel_attention(x, w_qkv_a[j], w_o_a[j], rel_bias)
        else:
            y = stick_breaking_attention(x, w_qkv_b[j], w_o_b[j])
        x = layer_norm(ALPHA * x + y, ln_g[i, 1], ln_b[i, 1])
        h = swiglu(x, ffn_w_gate[i, 1], ffn_w_up[i, 1], ffn_w_down[i, 1])
        x = layer_norm(ALPHA * x + 0.5 * h, ln_g[i, 2], ln_b[i, 2])
    return x
```

```cpp
#include <hip/hip_runtime.h>
#include <hip/hip_cooperative_groups.h>
#include <cstdio>
#include <cstdint>
namespace cg = cooperative_groups;
namespace pg8 {
#define PG8_LAS __attribute__((address_space(3)))
typedef unsigned short bf16_t;
typedef short bf16x8 __attribute__((ext_vector_type(8)));
typedef float f32x4 __attribute__((ext_vector_type(4)));
typedef unsigned u32x4 __attribute__((ext_vector_type(4)));
constexpr int BM = 256, BK = 64, HALF = 128, HTB = HALF * BK * 2  , STAGE_BYTES = 8 * HTB, NXCD = 8, WGM = 8;

__host__ __device__ __forceinline__ int lds_byte(int r, int c) { const int st = (r >> 4) * 2 + (c >> 5), rr = r & 15, cc = c & 31, ob = rr * 64 + cc * 2; return st * 1024 + (ob ^ (((ob >> 9) & 1) << 5)); }
__host__ __device__ __forceinline__ void stage_rc(int b, int& R, int& C) { const int st = b / 1024, sb = b % 1024, swz = sb ^ (((sb >> 9) & 1) << 5); R = (st >> 1) * 16 + swz / 64; C = (st & 1) * 32 + (swz % 64) / 2; }
__host__ __device__ __forceinline__ int perm32(int rho) { const int n = rho >> 4, i = rho & 15; return 8 * (i >> 2) + 4 * n + (i & 3); }

struct Unit { int pm, pn; };
struct Gemm { const bf16_t* A; const bf16_t* Bt; int M, N, K; };

struct StaticOrder {
    int nM, nN, nwg, G, c;
    __host__ __device__ void init(int M, int N, int G_, int c_) { nM = M / BM; nN = N / BM; nwg = nM * nN; G = G_; c = c_; }
    __host__ __device__ bool next(int i, Unit& u) const {
        const long L = (long)i * G + c; if (L >= nwg) return false;
        int wgid = (int)L; { const int q = nwg / NXCD, r = nwg % NXCD, xcd = wgid % NXCD, off = wgid / NXCD; wgid = (xcd < r ? xcd * (q + 1) : r * (q + 1) + (xcd - r) * q) + off; }
        const int nig = WGM * nN, gid = wgid / nig, fm = gid * WGM, gsz = (nM - fm) < WGM ? (nM - fm) : WGM;
        u.pm = fm + ((wgid % nig) % gsz); u.pn = (wgid % nig) / gsz; return true;
    }
    __device__ __forceinline__ void a_ready(const Unit&) const {}
    __device__ __forceinline__ void done(const Unit&) const {}
};

__device__ __forceinline__ unsigned cvt_pk_bf16(float lo, float hi) { unsigned r; asm volatile("v_cvt_pk_bf16_f32 %0, %1, %2" : "=v"(r) : "v"(lo), "v"(hi)); return r; }
typedef float f32x2 __attribute__((ext_vector_type(2)));
__device__ __forceinline__ float ld_agent_f32(const float* p) { return __hip_atomic_load(p, __ATOMIC_RELAXED, __HIP_MEMORY_SCOPE_AGENT); }
typedef unsigned u32x2 __attribute__((ext_vector_type(2)));
__device__ __forceinline__ void row_stats8(const float* st, int row0, float (&mu)[2][4], float (&rs)[2][4]) {
#pragma unroll
    for (int ai = 0; ai < 2; ++ai)
#pragma unroll
        for (int m = 0; m < 4; ++m) { if (st) { const int row = row0 + ai * HALF + m * 16; const float s = ld_agent_f32(st + 2 * row), q = ld_agent_f32(st + 2 * row + 1);
            const float mm = s * (1.0f / 1024.0f), var = fmaxf(q * (1.0f / 1024.0f) - mm * mm, 0.f); mu[ai][m] = mm; rs[ai][m] = 1.0f / sqrtf(var + 1e-5f); } else { mu[ai][m] = 0.f; rs[ai][m] = 1.f; } }
}
struct EpiSwiglu {
    static constexpr bool PERM = true, AFTER_DRAIN = false;
    bf16_t* H; const float* stat; const float* cs; const float* bw;
    __device__ __forceinline__ void operator()(const f32x4 (&acc)[2][2][4][2], const Unit& u, int wr, int wc, int fr, int fq) const {
        const int row0 = u.pm * BM + wr * 64 + fr; const int cc = u.pn * BM + wc * 32 + 8 * fq; const int hc = u.pn * HALF + wc * 32 + 8 * fq;
        float mu[2][4], rs[2][4]; row_stats8(stat, row0, mu, rs);
#pragma unroll
        for (int n = 0; n < 2; ++n) { const f32x4 csg = *(const f32x4*)(cs + cc + 4 * n), csu = *(const f32x4*)(cs + cc + HALF + 4 * n), bwg = *(const f32x4*)(bw + cc + 4 * n), bwu = *(const f32x4*)(bw + cc + HALF + 4 * n);
#pragma unroll
            for (int ai = 0; ai < 2; ++ai)
#pragma unroll
                for (int m = 0; m < 4; ++m) { const int row = row0 + ai * HALF + m * 16;
                    const f32x4 g = (acc[ai][0][m][n] - csg * mu[ai][m]) * rs[ai][m] + bwg, up = (acc[ai][1][m][n] - csu * mu[ai][m]) * rs[ai][m] + bwu; f32x4 hv;
#pragma unroll
                    for (int j = 0; j < 4; ++j) { const float e = __builtin_amdgcn_exp2f(g[j] * -1.4426950408889634f); hv[j] = g[j] * up[j] * __builtin_amdgcn_rcpf(1.0f + e); }
                    u32x2 w; w.x = cvt_pk_bf16(hv[0], hv[1]); w.y = cvt_pk_bf16(hv[2], hv[3]);
                    *(u32x2*)(H + (size_t)row * 2816 + hc + 4 * n) = w; } }
    }
};
struct EpiQKV {
    static constexpr bool PERM = true, AFTER_DRAIN = false;
    bf16_t* Q; size_t tstride; const float* stat; const float* cs; const float* bw; float qscale;
    __device__ __forceinline__ void operator()(const f32x4 (&acc)[2][2][4][2], const Unit& u, int wr, int wc, int fr, int fq) const {
        const int row0 = u.pm * BM + wr * 64 + fr; const int cc = u.pn * BM + wc * 32 + 8 * fq;
        const int t = (u.pn * BM) >> 10; bf16_t* base = Q + (size_t)t * tstride; const int col0 = ((u.pn * BM) & 1023) + wc * 32 + 8 * fq; const float sc = (t == 0) ? qscale : 1.0f;
        float mu[2][4], rs[2][4]; row_stats8(stat, row0, mu, rs);
#pragma unroll
        for (int bj = 0; bj < 2; ++bj)
#pragma unroll
            for (int n = 0; n < 2; ++n) { const f32x4 csv = *(const f32x4*)(cs + cc + bj * HALF + 4 * n), bwv = *(const f32x4*)(bw + cc + bj * HALF + 4 * n);
#pragma unroll
                for (int ai = 0; ai < 2; ++ai)
#pragma unroll
                    for (int m = 0; m < 4; ++m) { const int row = row0 + ai * HALF + m * 16; const f32x4 v = ((acc[ai][bj][m][n] - csv * mu[ai][m]) * rs[ai][m] + bwv) * sc;
                        u32x2 w; w.x = cvt_pk_bf16(v[0], v[1]); w.y = cvt_pk_bf16(v[2], v[3]);
                        *(u32x2*)(base + (size_t)row * 1024 + col0 + bj * HALF + 4 * n) = w; } }
    }
};
struct EpiResid {
    static constexpr bool PERM = true, AFTER_DRAIN = false;
    const float* zin; float* zout; bf16_t* zb; const float* stat_in; const PG8_LAS float* gb; float* stat_out; float coef;
    __device__ __forceinline__ void operator()(const f32x4 (&acc)[2][2][4][2], const Unit& u, int wr, int wc, int fr, int fq) const {
        constexpr float ALPHA = 1.681792830507429f;
        const int row0 = u.pm * BM + wr * 64 + fr; const int col0 = u.pn * BM + wc * 32 + 8 * fq;
#pragma unroll
        for (int ai = 0; ai < 2; ++ai)
#pragma unroll
            for (int m = 0; m < 4; ++m) { const int row = row0 + ai * HALF + m * 16; const unsigned off = (unsigned)row * 1024u + (unsigned)col0;
                f32x4 zr[2][2];
#pragma unroll
                for (int bj = 0; bj < 2; ++bj)
#pragma unroll
                    for (int n = 0; n < 2; ++n) zr[bj][n] = *(const f32x4*)(zin + off + bj * HALF + 4 * n);
                float mu = 0.f, rs = 1.f;
                if (stat_in) { const float s = ld_agent_f32(stat_in + 2 * row), q = ld_agent_f32(stat_in + 2 * row + 1); mu = s * (1.0f / 1024.0f); const float var = fmaxf(q * (1.0f / 1024.0f) - mu * mu, 0.f); rs = 1.0f / sqrtf(var + 1e-5f); }
                float s = 0.f, q = 0.f;
#pragma unroll
                for (int bj = 0; bj < 2; ++bj) { f32x4 zn[2];
#pragma unroll
                    for (int n = 0; n < 2; ++n) { f32x4 xn = zr[bj][n];
                        if (stat_in) { const f32x4 gv = *(const PG8_LAS f32x4*)(gb + col0 + bj * HALF + 4 * n), bv = *(const PG8_LAS f32x4*)(gb + 1024 + col0 + bj * HALF + 4 * n); xn = (xn - mu) * rs * gv + bv; }
                        zn[n] = xn * ALPHA + acc[ai][bj][m][n] * coef;
                        *(f32x4*)(zout + off + bj * HALF + 4 * n) = zn[n];
                        s += (zn[n][0] + zn[n][1]) + (zn[n][2] + zn[n][3]); q += (zn[n][0] * zn[n][0] + zn[n][1] * zn[n][1]) + (zn[n][2] * zn[n][2] + zn[n][3] * zn[n][3]); }
                    u32x4 w; w.x = cvt_pk_bf16(zn[0][0], zn[0][1]); w.y = cvt_pk_bf16(zn[0][2], zn[0][3]); w.z = cvt_pk_bf16(zn[1][0], zn[1][1]); w.w = cvt_pk_bf16(zn[1][2], zn[1][3]);
                    *(u32x4*)(zb + off + bj * HALF) = w; }
                s += __shfl_xor(s, 16); s += __shfl_xor(s, 32); q += __shfl_xor(q, 16); q += __shfl_xor(q, 32);
                if (fq == 0) unsafeAtomicAdd(stat_out + 2 * row, s); else if (fq == 1) unsafeAtomicAdd(stat_out + 2 * row + 1, q);
                if (m & 1) asm volatile("" ::: "memory"); }
    }
};

template <class Epi, class Sched, bool ALIGN_EPI = false, bool SP2 = false>
__device__ __forceinline__ void gemm_phase(PG8_LAS unsigned char* lds, const int tid, const Gemm g, const Sched& S, const Epi& E) {
    const int  wid = __builtin_amdgcn_readfirstlane(tid >> 6), lane = tid & 63, wr = wid >> 2, wc = wid & 3, fr = lane & 15, fq = lane >> 4;
    const int K = g.K, nt = K / BK;
    unsigned voffA[2], voffB[2];
#pragma unroll
    for (int i = 0; i < 2; ++i) { int R, C; stage_rc(tid * 16 + i * 8192, R, C); const int Rb = Epi::PERM ? ((R & ~31) + perm32(R & 31)) : R;
        voffA[i] = (unsigned)(R * K + C) * 2u; voffB[i] = (unsigned)(Rb * K + C) * 2u; }
    const size_t kstep = (size_t)(BK * 2);
    const size_t hstep = (size_t)HALF * K * 2;
    const size_t tstep = 2 * hstep;
    const unsigned ldsw = (unsigned)wid * 1024u;
    const int aoff = lds_byte(wr * 64 + fr, fq * 8), boff = lds_byte(wc * 32 + fr, fq * 8);
#define PG8_SA(b, h) (((b) * 2 + (h)) * HTB)
#define PG8_SB(b, h) ((4 + (b) * 2 + (h)) * HTB)
#define PG8_STAGE(bufoff, gbase, voff) do { _Pragma("unroll") for (int _i = 0; _i < 2; ++_i) \
        __builtin_amdgcn_global_load_lds((const unsigned*)((const char*)(gbase) + (voff)[_i]), (PG8_LAS unsigned*)(lds + (bufoff) + ldsw + _i * 8192), 16, 0, 0); } while (0)
#define PG8_LDA(dst, b, h) do { _Pragma("unroll") for (int m = 0; m < 4; ++m) _Pragma("unroll") for (int k = 0; k < 2; ++k) dst[m][k] = *(const PG8_LAS bf16x8*)(lds + PG8_SA(b, h) + aoff + m * 2048 + k * 1024); } while (0)
#define PG8_LDB(dst, b, h) do { _Pragma("unroll") for (int n = 0; n < 2; ++n) _Pragma("unroll") for (int k = 0; k < 2; ++k) dst[n][k] = *(const PG8_LAS bf16x8*)(lds + PG8_SB(b, h) + boff + n * 2048 + k * 1024); } while (0)
#define PG8_MMA(ai, bj, At, Bt) do { __builtin_amdgcn_s_setprio(1); _Pragma("unroll") for (int m = 0; m < 4; ++m) _Pragma("unroll") for (int n = 0; n < 2; ++n) _Pragma("unroll") for (int k = 0; k < 2; ++k) \
        acc[ai][bj][m][n] = __builtin_amdgcn_mfma_f32_16x16x32_bf16(Bt[n][k], At[m][k], acc[ai][bj][m][n], 0, 0, 0); __builtin_amdgcn_s_setprio(0); } while (0)
#define PG8_WAIT_V(n) asm volatile("s_waitcnt vmcnt(" #n ")" ::: "memory")
#define PG8_WAIT_L(n) asm volatile("s_waitcnt lgkmcnt(" #n ")" ::: "memory")
#define PG8_BAR __builtin_amdgcn_s_barrier()
#define PG8_SCHED __builtin_amdgcn_sched_barrier(0)
    Unit cur, nxt; int ui = 0;
    if (!S.next(0, cur)) return;
    f32x4 acc[2][2][4][2];
#pragma unroll
    for (int a = 0; a < 2; ++a)
#pragma unroll
        for (int b = 0; b < 2; ++b)
#pragma unroll
            for (int m = 0; m < 4; ++m)
#pragma unroll
                for (int n = 0; n < 2; ++n) acc[a][b][m][n] = (f32x4){0.f, 0.f, 0.f, 0.f};
    bf16x8 At[4][2], B0[2][2], B1[2][2];
    const char* cA = (const char*)g.A + (size_t)cur.pm * tstep; const char* cB = (const char*)g.Bt + (size_t)cur.pn * tstep;
    S.a_ready(cur);
    if constexpr (SP2) {
        PG8_STAGE(PG8_SB(0, 0), cB, voffB); PG8_STAGE(PG8_SB(0, 1), cB + hstep, voffB); PG8_STAGE(PG8_SA(0, 0), cA, voffA); PG8_STAGE(PG8_SA(0, 1), cA + hstep, voffA);
        if (wr == 1) PG8_BAR;
        PG8_WAIT_V(2); PG8_BAR;
        PG8_STAGE(PG8_SB(1, 0), cB + kstep, voffB); PG8_STAGE(PG8_SA(1, 0), cA + kstep, voffA); PG8_STAGE(PG8_SB(1, 1), cB + hstep + kstep, voffB);
        PG8_WAIT_V(6); PG8_BAR;
    } else {
        PG8_STAGE(PG8_SB(0, 0), cB, voffB); PG8_STAGE(PG8_SA(0, 0), cA, voffA); PG8_STAGE(PG8_SB(0, 1), cB + hstep, voffB); PG8_STAGE(PG8_SA(0, 1), cA + hstep, voffA);
        if (wr == 1) PG8_BAR;
        PG8_WAIT_V(4); PG8_BAR;
        PG8_STAGE(PG8_SB(1, 0), cB + kstep, voffB); PG8_STAGE(PG8_SA(1, 0), cA + kstep, voffA); PG8_STAGE(PG8_SB(1, 1), cB + hstep + kstep, voffB);
        PG8_WAIT_V(6); PG8_BAR;
    }
    for (;;) {
        const bool has_next = S.next(ui + 1, nxt);
        const char* nA = has_next ? (const char*)g.A + (size_t)nxt.pm * tstep : cA; const char* nB = has_next ? (const char*)g.Bt + (size_t)nxt.pn * tstep : cB;
        for (int t = 0; t < nt; t += 2) {
            const bool last = (t == nt - 2);
            const char* a1 = cA + (size_t)(t + 1) * kstep;
            const char* a2 = last ? nA : cA + (size_t)(t + 2) * kstep; const char* b2 = last ? nB : cB + (size_t)(t + 2) * kstep;
            const char* a3 = a2 + kstep; const char* b3 = b2 + kstep;
            if (last && has_next) S.a_ready(nxt);
            if constexpr (SP2) {
            PG8_LDB(B0, 0, 0); PG8_LDB(B1, 0, 1); PG8_SCHED; PG8_LDA(At, 0, 0); PG8_STAGE(PG8_SA(1, 1), a1 + hstep, voffA);
            PG8_WAIT_V(8); PG8_WAIT_L(0); PG8_BAR; PG8_MMA(0, 0, At, B0); PG8_MMA(0, 1, At, B1); PG8_BAR; PG8_SCHED;
            PG8_LDA(At, 0, 1); PG8_STAGE(PG8_SB(0, 0), b2, voffB); PG8_STAGE(PG8_SB(0, 1), b2 + hstep, voffB); PG8_STAGE(PG8_SA(0, 0), a2, voffA);
            PG8_WAIT_V(8); PG8_WAIT_L(0); PG8_BAR; PG8_MMA(1, 0, At, B0); PG8_MMA(1, 1, At, B1); PG8_BAR; PG8_SCHED;
            PG8_LDB(B0, 1, 0); PG8_LDB(B1, 1, 1); PG8_SCHED; PG8_LDA(At, 1, 0); PG8_STAGE(PG8_SA(0, 1), a2 + hstep, voffA);
            PG8_WAIT_V(8); PG8_WAIT_L(0); PG8_BAR; PG8_MMA(0, 0, At, B0); PG8_MMA(0, 1, At, B1); PG8_BAR; PG8_SCHED;
            PG8_LDA(At, 1, 1); PG8_STAGE(PG8_SB(1, 0), b3, voffB); PG8_STAGE(PG8_SB(1, 1), b3 + hstep, voffB); PG8_STAGE(PG8_SA(1, 0), a3, voffA);
            PG8_WAIT_V(8); PG8_WAIT_L(0); PG8_BAR; PG8_MMA(1, 0, At, B0); PG8_MMA(1, 1, At, B1); PG8_BAR; PG8_SCHED;
            } else {
            PG8_LDB(B0, 0, 0); PG8_SCHED; PG8_LDA(At, 0, 0); PG8_STAGE(PG8_SA(1, 1), a1 + hstep, voffA);
            PG8_WAIT_L(8); PG8_BAR; PG8_WAIT_L(0); PG8_MMA(0, 0, At, B0); PG8_BAR; PG8_SCHED;
            PG8_LDB(B1, 0, 1); PG8_STAGE(PG8_SB(0, 0), b2, voffB);
            PG8_BAR; PG8_WAIT_L(0); PG8_MMA(0, 1, At, B1); PG8_BAR;
            PG8_LDA(At, 0, 1); PG8_STAGE(PG8_SA(0, 0), a2, voffA);
            PG8_BAR; PG8_WAIT_L(0); PG8_MMA(1, 0, At, B0); PG8_BAR; PG8_SCHED;
            PG8_STAGE(PG8_SB(0, 1), b2 + hstep, voffB);
            PG8_WAIT_V(6); PG8_BAR; PG8_MMA(1, 1, At, B1); PG8_BAR;
            PG8_LDB(B0, 1, 0); PG8_SCHED; PG8_LDA(At, 1, 0); PG8_STAGE(PG8_SA(0, 1), a2 + hstep, voffA);
            PG8_WAIT_L(8); PG8_BAR; PG8_WAIT_L(0); PG8_MMA(0, 0, At, B0); PG8_BAR; PG8_SCHED;
            PG8_LDB(B1, 1, 1); PG8_STAGE(PG8_SB(1, 0), b3, voffB);
            PG8_BAR; PG8_WAIT_L(0); PG8_MMA(0, 1, At, B1); PG8_BAR;
            PG8_LDA(At, 1, 1); PG8_STAGE(PG8_SA(1, 0), a3, voffA);
            PG8_BAR; PG8_WAIT_L(0); PG8_MMA(1, 0, At, B0); PG8_BAR; PG8_SCHED;
            PG8_STAGE(PG8_SB(1, 1), b3 + hstep, voffB);
            PG8_WAIT_V(6); PG8_BAR; PG8_MMA(1, 1, At, B1); PG8_BAR;
            }
        }
        if constexpr (ALIGN_EPI) { if (wr == 0) PG8_BAR; }
        if constexpr (!Epi::AFTER_DRAIN) { E(acc, cur, wr, wc, fr, fq); S.done(cur); }
        if (!has_next) break;
#pragma unroll
        for (int a = 0; a < 2; ++a)
#pragma unroll
            for (int b = 0; b < 2; ++b)
#pragma unroll
                for (int m = 0; m < 4; ++m)
#pragma unroll
                    for (int n = 0; n < 2; ++n) acc[a][b][m][n] = (f32x4){0.f, 0.f, 0.f, 0.f};
        cur = nxt; cA = nA; cB = nB; ++ui;
        if constexpr (ALIGN_EPI) { if (wr == 1) PG8_BAR; }
    }
    PG8_WAIT_V(0);
    if constexpr (!ALIGN_EPI) { if (wr == 0) PG8_BAR; }
    PG8_BAR;
    if constexpr (Epi::AFTER_DRAIN) { E.fused(acc, cur, wr, wc, fr, fq, lds, wid, lane); S.done(cur); }
#undef PG8_SA
#undef PG8_SB
#undef PG8_STAGE
#undef PG8_LDA
#undef PG8_LDB
#undef PG8_MMA
#undef PG8_WAIT_V
#undef PG8_WAIT_L
#undef PG8_BAR
#undef PG8_SCHED
}
}
namespace att {
#define ALAS __attribute__((address_space(3)))
typedef unsigned short bf16_t;
typedef short bf16x8 __attribute__((ext_vector_type(8)));
typedef short s16x4 __attribute__((ext_vector_type(4)));
typedef float f32x16 __attribute__((ext_vector_type(16)));
typedef unsigned u32x4 __attribute__((ext_vector_type(4)));
constexpr int DM = 1024, SEQ = 2048;
constexpr int VHALF = 4096;
constexpr int L_KV = 0;
constexpr int L_WSF = 65536;
constexpr int L_TAB = 65536 + 2048;
constexpr int L_OST = 65536 + 8192;
constexpr int L_FLAG = L_OST + 32768;
constexpr float LOG2E = 1.4426950408889634f;
__device__ __forceinline__ int crow(int r, int hi) { return (r & 3) + 8 * (r >> 2) + 4 * hi; }
__device__ __forceinline__ unsigned cvtpk(float lo, float hi) { unsigned r; asm volatile("v_cvt_pk_bf16_f32 %0, %1, %2" : "=v"(r) : "v"(lo), "v"(hi)); return r; }
typedef short v4i16_t __attribute__((ext_vector_type(4)));
__device__ __forceinline__ s16x4 vtr(const ALAS unsigned char* p) { return __builtin_bit_cast(s16x4, __builtin_amdgcn_ds_read_tr16_b64_v4i16((ALAS v4i16_t*)p)); }

struct Stage { u32x4 k[2], v[2]; };
__device__ __forceinline__ void stage_load(Stage& s, const bf16_t* Kg, const bf16_t* Vg, long tok0, int hcol, int t256) {
#pragma unroll
    for (int i = 0; i < 2; ++i) { const int cid = t256 + 256 * i, row = cid >> 3, ch = cid & 7; const size_t o = (size_t)(tok0 + row) * DM + hcol + ch * 8;
        s.k[i] = *(const u32x4*)(Kg + o); s.v[i] = *(const u32x4*)(Vg + o); }
}
__device__ __forceinline__ void stage_store(const Stage& s, ALAS unsigned char* kbuf, ALAS unsigned char* vbuf, int t256) {
#pragma unroll
    for (int i = 0; i < 2; ++i) { const int cid = t256 + 256 * i, row = cid >> 3, ch = cid & 7;
        *(ALAS u32x4*)(kbuf + row * 128 + ((ch ^ ((row >> 1) & 7)) << 4)) = s.k[i];
        *(ALAS u32x4*)(vbuf + (ch >> 2) * VHALF + row * 64 + (ch & 3) * 16) = s.v[i]; }
}
__device__ __forceinline__ void qk_tile(f32x16& p0, f32x16& p1, const ALAS unsigned char* kbuf, const bf16x8 (&qr)[4], int r32, int hi) {
    const f32x16 z = {}; p0 = z; p1 = z;
    const int sw = (r32 >> 1) & 7;
#pragma unroll
    for (int d0 = 0; d0 < 4; ++d0) { const int ch = 2 * d0 + hi;
        const bf16x8 a0 = *(const ALAS bf16x8*)(kbuf + r32 * 128 + ((ch ^ sw) << 4));
        const bf16x8 a1 = *(const ALAS bf16x8*)(kbuf + (r32 + 32) * 128 + ((ch ^ sw) << 4));
        p0 = __builtin_amdgcn_mfma_f32_32x32x16_bf16(a0, qr[d0], p0, 0, 0, 0);
        p1 = __builtin_amdgcn_mfma_f32_32x32x16_bf16(a1, qr[d0], p1, 0, 0, 0); }
}
__device__ __forceinline__ void pv_tile(f32x16 (&o)[2], const ALAS unsigned char* vbuf, const f32x16& p0, const f32x16& p1, int lane, int hi) {
    u32x4 pw[4];
#pragma unroll
    for (int k = 0; k < 2; ++k) { pw[k] = (u32x4){cvtpk(p0[8 * k + 0], p0[8 * k + 1]), cvtpk(p0[8 * k + 2], p0[8 * k + 3]), cvtpk(p0[8 * k + 4], p0[8 * k + 5]), cvtpk(p0[8 * k + 6], p0[8 * k + 7])};
        pw[2 + k] = (u32x4){cvtpk(p1[8 * k + 0], p1[8 * k + 1]), cvtpk(p1[8 * k + 2], p1[8 * k + 3]), cvtpk(p1[8 * k + 4], p1[8 * k + 5]), cvtpk(p1[8 * k + 6], p1[8 * k + 7])}; }
    const ALAS unsigned char* vp = vbuf + ((lane >> 4) & 1) * 32 + (lane & 3) * 8 + (4 * hi + ((lane & 15) >> 2)) * 64;
#pragma unroll
    for (int d0 = 0; d0 < 2; ++d0)
#pragma unroll
        for (int ks = 0; ks < 4; ++ks) { const s16x4 lo = vtr(vp + d0 * VHALF + ks * 1024), hh = vtr(vp + d0 * VHALF + ks * 1024 + 512);
            const bf16x8 vb = (bf16x8){lo[0], lo[1], lo[2], lo[3], hh[0], hh[1], hh[2], hh[3]};
            o[d0] = __builtin_amdgcn_mfma_f32_32x32x16_bf16(__builtin_bit_cast(bf16x8, pw[ks]), vb, o[d0], 0, 0, 0); }
}
__device__ __forceinline__ void store_o(const f32x16 (&o)[2], ALAS unsigned char* lds, int wid, int lane, int r32, int hi, bf16_t* Og  , bool scaled) {
    ALAS float* wsf = (ALAS float*)(lds + L_WSF) + wid * 64;
    ALAS bf16_t* stg = (ALAS bf16_t*)(lds + L_OST) + wid * 2048;
#pragma unroll
    for (int r = 0; r < 16; ++r) { const int orow = crow(r, hi); const float sc = scaled ? wsf[orow] : 1.0f;
#pragma unroll
        for (int d0 = 0; d0 < 2; ++d0) { const unsigned w = cvtpk(o[d0][r] * sc, 0.f); stg[orow * 64 + d0 * 32 + r32] = (bf16_t)(w & 0xffffu); } }
    asm volatile("s_waitcnt lgkmcnt(0)" ::: "memory");
#pragma unroll
    for (int i = 0; i < 4; ++i) { const int row = i * 8 + (lane >> 3), ch = lane & 7; const u32x4 v = *(const ALAS u32x4*)(stg + row * 64 + ch * 8); *(u32x4*)(Og + (size_t)row * DM + ch * 8) = v; }
    asm volatile("s_waitcnt lgkmcnt(0)" ::: "memory");
}

__device__ __forceinline__ void chunk_attn_unit(int b, int hp, int qblk, const bf16_t* Q, const bf16_t* K, const bf16_t* V, bf16_t* O, const float* rel, ALAS unsigned char* lds, const int tid) {
    const int lane = tid & 63, r32 = lane & 31, hi = lane >> 5, wid = __builtin_amdgcn_readfirstlane(tid >> 6), half = wid >> 2, w4 = wid & 3, t256 = tid & 255;
    const int h = 2 * hp + half, hcol = h * 64; const long tokb = (long)b * SEQ;
    const int cq = 2 * qblk + (w4 >> 1), iq0 = (w4 & 1) * 32, tq0 = cq * 64 + iq0;
    ALAS float* wsf = (ALAS float*)(lds + L_WSF) + wid * 64;
    ALAS float* tab = (ALAS float*)(lds + L_TAB) + half * 260;
    bf16x8 qr[4];
#pragma unroll
    for (int d0 = 0; d0 < 4; ++d0) qr[d0] = *(const bf16x8*)(Q + (size_t)(tokb + tq0 + r32) * DM + hcol + d0 * 16 + hi * 8);
    for (int i = t256; i < 257; i += 256) tab[i] = rel[i * 16 + h] * LOG2E;
    const int kc_lo = (2 * qblk - 8) > 0 ? (2 * qblk - 8) : 0, n = 2 * qblk + 1 - kc_lo + 1;
    Stage st; stage_load(st, K, V, tokb + (long)kc_lo * 64, hcol, t256);
    stage_store(st, lds + L_KV + ((0 * 2 + half) * 2 + 0) * 8192, lds + L_KV + ((0 * 2 + half) * 2 + 1) * 8192, t256);
    __syncthreads();
    float mrun = -INFINITY, lrun = 0.f; f32x16 o[2]; o[0] = (f32x16){}; o[1] = (f32x16){};
    for (int i = 0; i < n; ++i) { const int kc = kc_lo + i, bufc = i & 1;
        if (i + 1 < n) stage_load(st, K, V, tokb + (long)(kc + 1) * 64, hcol, t256);
        if (kc >= cq - 8 && kc <= cq) {
            const ALAS unsigned char* kbuf = lds + L_KV + ((bufc * 2 + half) * 2 + 0) * 8192; const ALAS unsigned char* vbuf = kbuf + 8192;
            f32x16 p0, p1; qk_tile(p0, p1, kbuf, qr, r32, hi);
            const int delta = cq - kc;
            if (delta >= 3) { const float bc = tab[256];
#pragma unroll
                for (int r = 0; r < 16; ++r) { p0[r] += bc; p1[r] += bc; } }
            else { const int base = delta * 64 + iq0 + r32 + 128;
#pragma unroll
                for (int r = 0; r < 16; ++r) { const int i0 = base - crow(r, hi), i1 = i0 - 32; p0[r] += tab[i0 > 256 ? 256 : i0]; p1[r] += tab[i1 > 256 ? 256 : i1]; } }
            float mx = fmaxf(p0[0], p1[0]);
#pragma unroll
            for (int r = 1; r < 16; ++r) mx = fmaxf(mx, fmaxf(p0[r], p1[r]));
            mx = fmaxf(mx, __shfl_xor(mx, 32));
            const float mn = fmaxf(mrun, mx), f = __builtin_amdgcn_exp2f(mrun - mn); mrun = mn;
            float rs = 0.f;
#pragma unroll
            for (int r = 0; r < 16; ++r) { p0[r] = __builtin_amdgcn_exp2f(p0[r] - mn); p1[r] = __builtin_amdgcn_exp2f(p1[r] - mn); rs += p0[r] + p1[r]; }
            rs += __shfl_xor(rs, 32);
            lrun = lrun * f + rs;
            if (__any(f != 1.0f)) { if (hi == 0) wsf[r32] = f; asm volatile("s_waitcnt lgkmcnt(0)" ::: "memory");
#pragma unroll
                for (int r = 0; r < 16; ++r) { const float ff = wsf[crow(r, hi)]; o[0][r] *= ff; o[1][r] *= ff; }
                asm volatile("s_waitcnt lgkmcnt(0)" ::: "memory"); }
            pv_tile(o, vbuf, p0, p1, lane, hi);
        }
        if (i + 1 < n) stage_store(st, lds + L_KV + (((bufc ^ 1) * 2 + half) * 2 + 0) * 8192, lds + L_KV + (((bufc ^ 1) * 2 + half) * 2 + 1) * 8192, t256);
        __syncthreads();
    }
    if (hi == 0) wsf[r32] = 1.0f / lrun;
    asm volatile("s_waitcnt lgkmcnt(0)" ::: "memory");
    store_o(o, lds, wid, lane, r32, hi, O + (size_t)(tokb + tq0) * DM + hcol, true);
}

__device__ __forceinline__ void stick_attn_unit(int b, int hp, int qb, const bf16_t* Q, const bf16_t* K, const bf16_t* V, bf16_t* O, ALAS unsigned char* lds, const int tid) {
    const int lane = tid & 63, r32 = lane & 31, hi = lane >> 5, wid = __builtin_amdgcn_readfirstlane(tid >> 6), half = wid >> 2, w4 = wid & 3, t256 = tid & 255;
    const int h = 2 * hp + half, hcol = h * 64; const long tokb = (long)b * SEQ;
    const int tq0 = qb * 128 + w4 * 32, tq = tq0 + r32;
    bf16x8 qr[4];
#pragma unroll
    for (int d0 = 0; d0 < 4; ++d0) qr[d0] = *(const bf16x8*)(Q + (size_t)(tokb + tq) * DM + hcol + d0 * 16 + hi * 8);
    const int n = 2 * qb + 2;
    Stage st; stage_load(st, K, V, tokb + (long)(n - 1) * 64, hcol, t256);
    stage_store(st, lds + L_KV + ((0 * 2 + half) * 2 + 0) * 8192, lds + L_KV + ((0 * 2 + half) * 2 + 1) * 8192, t256);
    __syncthreads();
    float carry = 0.f; f32x16 o[2]; o[0] = (f32x16){}; o[1] = (f32x16){};
    for (int i = 0; i < n; ++i) { const int kt = n - 1 - i, k0 = kt * 64, bufc = i & 1;
        if (i + 1 < n) stage_load(st, K, V, tokb + (long)(kt - 1) * 64, hcol, t256);
        if (k0 < tq0 + 31) {
            const ALAS unsigned char* kbuf = lds + L_KV + ((bufc * 2 + half) * 2 + 0) * 8192; const ALAS unsigned char* vbuf = kbuf + 8192;
            f32x16 p0, p1; qk_tile(p0, p1, kbuf, qr, r32, hi);
            const bool needmask = (k0 + 63 >= tq0);
            f32x16 L0, L1;
#pragma unroll
            for (int r = 0; r < 16; ++r) {
                { const float zz = p0[r], e = __builtin_amdgcn_exp2f(-fabsf(zz)), lsp = __builtin_amdgcn_logf(1.0f + e); float lb = fminf(zz, 0.f) - lsp, l1 = lb - zz;
                  if (needmask && (k0 + crow(r, hi) >= tq)) { lb = -INFINITY; l1 = 0.f; } p0[r] = lb; L0[r] = l1; }
                { const float zz = p1[r], e = __builtin_amdgcn_exp2f(-fabsf(zz)), lsp = __builtin_amdgcn_logf(1.0f + e); float lb = fminf(zz, 0.f) - lsp, l1 = lb - zz;
                  if (needmask && (k0 + 32 + crow(r, hi) >= tq)) { lb = -INFINITY; l1 = 0.f; } p1[r] = lb; L1[r] = l1; }
            }
            float g0[4], g1[4], pg0[4], pg1[4];
#pragma unroll
            for (int g = 0; g < 4; ++g) { g0[g] = (L0[4 * g] + L0[4 * g + 1]) + (L0[4 * g + 2] + L0[4 * g + 3]); g1[g] = (L1[4 * g] + L1[4 * g + 1]) + (L1[4 * g + 2] + L1[4 * g + 3]); }
#pragma unroll
            for (int g = 0; g < 4; ++g) { pg0[g] = __shfl_xor(g0[g], 32); pg1[g] = __shfl_xor(g1[g], 32); }
            float suff = 0.f;
#pragma unroll
            for (int g = 3; g >= 0; --g) { const float e3 = carry + suff + (hi == 0 ? pg1[g] : 0.f), e2 = e3 + L1[4 * g + 3], e1 = e2 + L1[4 * g + 2], e0 = e1 + L1[4 * g + 1];
                p1[4 * g + 3] = __builtin_amdgcn_exp2f(p1[4 * g + 3] + e3); p1[4 * g + 2] = __builtin_amdgcn_exp2f(p1[4 * g + 2] + e2);
                p1[4 * g + 1] = __builtin_amdgcn_exp2f(p1[4 * g + 1] + e1); p1[4 * g + 0] = __builtin_amdgcn_exp2f(p1[4 * g + 0] + e0);
                suff += g1[g] + pg1[g]; }
            carry += suff; suff = 0.f;
#pragma unroll
            for (int g = 3; g >= 0; --g) { const float e3 = carry + suff + (hi == 0 ? pg0[g] : 0.f), e2 = e3 + L0[4 * g + 3], e1 = e2 + L0[4 * g + 2], e0 = e1 + L0[4 * g + 1];
                p0[4 * g + 3] = __builtin_amdgcn_exp2f(p0[4 * g + 3] + e3); p0[4 * g + 2] = __builtin_amdgcn_exp2f(p0[4 * g + 2] + e2);
                p0[4 * g + 1] = __builtin_amdgcn_exp2f(p0[4 * g + 1] + e1); p0[4 * g + 0] = __builtin_amdgcn_exp2f(p0[4 * g + 0] + e0);
                suff += g0[g] + pg0[g]; }
            carry += suff;
            pv_tile(o, vbuf, p0, p1, lane, hi);
        }
        if (i + 1 < n) stage_store(st, lds + L_KV + (((bufc ^ 1) * 2 + half) * 2 + 0) * 8192, lds + L_KV + (((bufc ^ 1) * 2 + half) * 2 + 1) * 8192, t256);
        __syncthreads();
    }
    store_o(o, lds, wid, lane, r32, hi, O + (size_t)(tokb + tq0) * DM + hcol, false);
}
#undef ALAS
}

#define GAS __attribute__((address_space(1)))
#define LAS __attribute__((address_space(3)))
typedef unsigned short bf16;
typedef unsigned v4u __attribute__((ext_vector_type(4)));
typedef float f32x4 __attribute__((ext_vector_type(4)));
typedef short bf16x8 __attribute__((ext_vector_type(8)));
typedef GAS unsigned gu32;
typedef GAS unsigned long long gu64;
#define RLX_AGENT __ATOMIC_RELAXED, __HIP_MEMORY_SCOPE_AGENT
#define LDS_WAIT() asm volatile("s_waitcnt lgkmcnt(0)" ::: "memory")
#define VM_WAIT() asm volatile("s_waitcnt vmcnt(0)" ::: "memory")
__device__ __forceinline__ unsigned long long rt() { return __builtin_amdgcn_s_memrealtime(); }
__device__ __forceinline__ unsigned f2bf(float f) { unsigned u = __builtin_bit_cast(unsigned, f); return (u + 0x7fffu + ((u >> 16) & 1u)) >> 16; }
__device__ __forceinline__ unsigned pk2(float lo, float hi) { return f2bf(lo) | (f2bf(hi) << 16); }

#define XB_TMO      128
#define XB_XCNT(j)  (256  + 64 * (j))
#define XB_XSUB(j)  (1280 + 64 * (j))
#define XB_XGEN(j)  (2304 + 64 * (j))
#define XB_TOP      3328
#define XB_TOPGEN   3392
#define XCD_BAR_WORDS 3456
#define XB_SPIN_CAP (1u << 18)

__device__ __forceinline__ unsigned xb_ld(unsigned* p)              { return __hip_atomic_load(p, __ATOMIC_RELAXED, __HIP_MEMORY_SCOPE_AGENT); }
__device__ __forceinline__ unsigned xb_add(unsigned* p, unsigned v) { return __hip_atomic_fetch_add(p, v, __ATOMIC_RELAXED, __HIP_MEMORY_SCOPE_AGENT); }
__device__ __forceinline__ unsigned xb_xcc_id() { return (unsigned)__builtin_amdgcn_s_getreg((3 << 11) | 20) & 0xFu; }
#define XB_SPIN(cond, bar) do { unsigned _sp = 0; while (cond) { __builtin_amdgcn_s_sleep(1); \
    if ((++_sp & 255u) == 0u) { if (xb_ld(&(bar)[XB_TMO])) break; if (_sp > XB_SPIN_CAP) { atomicAdd(&(bar)[XB_TMO], 1u); break; } } } } while (0)

struct XcdBarrier {
    unsigned* bar; unsigned x;
    volatile LAS unsigned* st;
};

__device__ __forceinline__ XcdBarrier xcd_barrier_post(unsigned* bar, volatile LAS unsigned* st) {
    XcdBarrier b; b.bar = bar; b.x = xb_xcc_id(); b.st = st;
    if (threadIdx.x == 0) (void)xb_add(&bar[XB_XCNT(b.x)], 1u);
    return b;
}
__device__ __forceinline__ void xcd_barrier_complete(unsigned* bar, unsigned x, unsigned& nloc, unsigned& nx) {
    const unsigned G = gridDim.x * gridDim.y * gridDim.z;
    unsigned sum, cnt, mine, sp = 0u;
    for (;;) {
        sum = 0u; cnt = 0u; mine = 0u;
#pragma unroll
        for (unsigned j = 0; j < 16; ++j) { const unsigned c = xb_ld(&bar[XB_XCNT(j)]); sum += c; cnt += (c > 0u) ? 1u : 0u; mine = (j == x) ? c : mine; }
        if (sum == G) break;
        __builtin_amdgcn_s_sleep(1);
        if ((++sp & 255u) == 0u) { if (xb_ld(&bar[XB_TMO])) break; if (sp > XB_SPIN_CAP) { atomicAdd(&bar[XB_TMO], 1u); break; } }
    }
    nloc = mine > 0u ? mine : 1u; nx = cnt > 0u ? cnt : 1u;
}

__device__ __forceinline__ void xcd_barrier(const XcdBarrier& b) {
    asm volatile("s_waitcnt vmcnt(0)" ::: "memory");
    __syncthreads();
    if (threadIdx.x == 0) {
        unsigned* bar = b.bar;
        __builtin_amdgcn_s_waitcnt(0);
        unsigned nloc = b.st[0], nx = b.st[1];
        if (nloc == 0u) { xcd_barrier_complete(bar, b.x, nloc, nx); b.st[0] = nloc; b.st[1] = nx; }
        const unsigned old = xb_add(&bar[XB_XSUB(b.x)], 1u);
        const unsigned gen = old / nloc;
        if (old + 1u == (gen + 1u) * nloc) {
            __builtin_amdgcn_fence(__ATOMIC_RELEASE, "agent");
            asm volatile("s_waitcnt vmcnt(0)" ::: "memory");
            const unsigned og = xb_add(&bar[XB_TOP], 1u);
            const unsigned tg = og / nx;
            if (og + 1u == (tg + 1u) * nx) xb_add(&bar[XB_TOPGEN], 1u);
            else XB_SPIN(xb_ld(&bar[XB_TOPGEN]) == tg, bar);
            __builtin_amdgcn_fence(__ATOMIC_ACQUIRE, "agent");
            xb_add(&bar[XB_XGEN(b.x)], 1u);
            asm volatile("s_waitcnt vmcnt(0)" ::: "memory");
        } else {
            XB_SPIN(xb_ld(&bar[XB_XGEN(b.x)]) == gen, bar);
            __builtin_amdgcn_fence(__ATOMIC_ACQUIRE, "agent");
            asm volatile("s_waitcnt vmcnt(0)" ::: "memory");
        }
    }
    __syncthreads();
}
constexpr int NWAVES = 8;
constexpr int BATCH = 16, SEQ = 2048, D = 1024, FF = 2816, DEPTH = 4, M = BATCH * SEQ;
constexpr size_t MiB = 1u << 20;
constexpr size_t WS_CTL = 0, CTL_ZERO_BYTES = 4 * MiB;
constexpr int CW_BAR = 1024;
constexpr size_t WS_CS = 64 * 1024, WS_BW = 320 * 1024;
constexpr int CSV_QKV = 8 * 2 * FF;
constexpr size_t WS_STAT = 1 * MiB;
constexpr size_t WS_W1 = 4 * MiB;
constexpr size_t WS_W2 = WS_W1 + 88 * MiB;
constexpr size_t WS_WQKV = WS_W2 + 44 * MiB;
constexpr size_t WS_WO = WS_WQKV + 24 * MiB;
constexpr size_t WS_ZB = WS_WO + 8 * MiB;
constexpr size_t WS_QKV = WS_ZB + 64 * MiB;
constexpr size_t WS_END = WS_QKV + 192 * MiB;
constexpr int LDS_STAGE = 131072, GB_OFF = LDS_STAGE, MISC_OFF = GB_OFF + 8192, LDS_BYTES = MISC_OFF + 512;


__device__ __forceinline__ void transpose_item(const float* W, int N, bf16* WT, int Kt, int k0, int n0, int dst_row0, const float* gvec, const float* bvec, float* cs, float* bw, LAS float* scr, int lane) {
    float csp = 0.f, bwp = 0.f;
#pragma unroll 8
    for (int i = 0; i < 32; ++i) { const int kk = 2 * i + (lane >> 5); const float w = W[(size_t)(k0 + kk) * N + n0 + (lane & 31)];
        const float gk = gvec ? gvec[k0 + kk] : 1.0f, bk = bvec ? bvec[k0 + kk] : 0.0f; const float wsc = w * gk; scr[kk * 33 + (lane & 31)] = wsc;
        csp += __builtin_bit_cast(float, f2bf(wsc) << 16); bwp += bk * w; }
    if (cs) { csp += __shfl_xor(csp, 32); bwp += __shfl_xor(bwp, 32);
        if (lane < 32) unsafeAtomicAdd(cs + dst_row0 + lane, csp); else unsafeAtomicAdd(bw + dst_row0 + (lane - 32), bwp); }
    LDS_WAIT(); asm volatile("" ::: "memory");
    const int c = lane & 7;
#pragma unroll
    for (int j = 0; j < 4; ++j) { const int n = (lane >> 3) + 8 * j; const LAS float* s = scr + (8 * c) * 33 + n;
        v4u o; o.x = pk2(s[0 * 33], s[1 * 33]); o.y = pk2(s[2 * 33], s[3 * 33]); o.z = pk2(s[4 * 33], s[5 * 33]); o.w = pk2(s[6 * 33], s[7 * 33]);
        *(v4u*)(WT + (size_t)(dst_row0 + n) * Kt + k0 + 8 * c) = o; }
    LDS_WAIT(); asm volatile("" ::: "memory");
}
__device__ __forceinline__ float wave_sum(float v) {
#pragma unroll
    for (int o = 1; o < 64; o <<= 1) v += __shfl_xor(v, o);
    return v;
}

struct Args { const float* in[11]; float* out; unsigned char* ws; };

__global__ void __launch_bounds__(NWAVES * 64, 2) fwd_megakernel(Args args) {
    extern __shared__ __attribute__((aligned(16))) unsigned char lds_raw[];
    LAS unsigned char* lds = (LAS unsigned char*)lds_raw;
    volatile LAS unsigned* MISC = (volatile LAS unsigned*)(lds + MISC_OFF);
    const int wave = __builtin_amdgcn_readfirstlane(threadIdx.x >> 6);
    const int G = gridDim.x, bx = blockIdx.x;
    unsigned char* ws = args.ws;
    unsigned* ctl = (unsigned*)(ws + WS_CTL);
    const float* x_in = args.in[0]; const float* rel = args.in[3]; const float* ln_g = args.in[9]; const float* ln_b = args.in[10];
    float* zout = args.out;
    float* CS = (float*)(ws + WS_CS); float* BW = (float*)(ws + WS_BW); float* STAT = (float*)(ws + WS_STAT);
    bf16* W1T = (bf16*)(ws + WS_W1); bf16* W2T = (bf16*)(ws + WS_W2); bf16* WQKVT = (bf16*)(ws + WS_WQKV); bf16* WOT = (bf16*)(ws + WS_WO);
    bf16* ZB = (bf16*)(ws + WS_ZB); bf16* QB = (bf16*)(ws + WS_QKV); bf16* KB = QB + (size_t)M * D; bf16* VB = KB + (size_t)M * D; bf16* HB = QB;
    for (int u = threadIdx.x; u < (LDS_BYTES - MISC_OFF) / 4; u += NWAVES * 64) ((LAS unsigned*)(lds + MISC_OFF))[u] = 0u;
    __syncthreads();
    XcdBarrier bar = xcd_barrier_post(ctl + CW_BAR, MISC + 8);

    {
        const int tid = threadIdx.x, lane = tid & 63;
        LAS float* scr = (LAS float*)(lds + wave * 16384);
        const int gw = bx * NWAVES + wave, NGW = G * NWAVES;
        constexpr int I_F = 16 * 88, N_FFN = 8 * 3 * I_F, I_QKV = 16 * 96, I_O = 16 * 32, N_MIX = 4 * (I_QKV + I_O);
        for (int it = gw; it < N_FFN + N_MIX; it += NGW) {
            if (it < N_FFN) { const int mi = it / I_F, r = it % I_F, f = mi / 3, which = mi % 3;
                if (which < 2) { const int kb = r / 88, nb = r % 88, n0 = 32 * nb, s = 3 * (f >> 1) + 2 * (f & 1);
                    const float* W = args.in[6 + which] + (size_t)f * D * FF;
                    const int dst = (n0 >> 7) * 256 + (n0 & 127) + which * 128;
                    transpose_item(W, FF, W1T + (size_t)f * 2 * FF * D, D, 64 * kb, n0, dst, s > 0 ? ln_g + (s - 1) * D : nullptr, s > 0 ? ln_b + (s - 1) * D : nullptr, CS + f * 2 * FF, BW + f * 2 * FF, scr, lane);
                } else { const int kb = r / 32, nb = r % 32;
                    transpose_item(args.in[8] + (size_t)f * FF * D, D, W2T + (size_t)f * D * FF, FF, 64 * kb, 32 * nb, 32 * nb, nullptr, nullptr, nullptr, nullptr, scr, lane); }
            } else { const int it2 = it - N_FFN, li = it2 / (I_QKV + I_O), r = it2 % (I_QKV + I_O), j = li >> 1, s = 3 * li + 1;
                if (r < I_QKV) { const int kb = r / 96, nb = r % 96;
                    const float* W = args.in[(li & 1) ? 4 : 1] + (size_t)j * D * 3 * D;
                    transpose_item(W, 3 * D, WQKVT + (size_t)li * 3 * D * D, D, 64 * kb, 32 * nb, 32 * nb, ln_g + (s - 1) * D, ln_b + (s - 1) * D, CS + CSV_QKV + li * 3 * D, BW + CSV_QKV + li * 3 * D, scr, lane);
                } else { const int r2 = r - I_QKV, kb = r2 / 32, nb = r2 % 32;
                    const float* W = args.in[(li & 1) ? 5 : 2] + (size_t)j * D * D;
                    transpose_item(W, D, WOT + (size_t)li * D * D, D, 64 * kb, 32 * nb, 32 * nb, nullptr, nullptr, nullptr, nullptr, scr, lane); }
            }
        }
        const size_t nch = (size_t)M * D / 8;
        for (size_t c = (size_t)bx * (NWAVES * 64) + tid; c < nch; c += (size_t)G * NWAVES * 64) {
            const f32x4 a = *(const f32x4*)(x_in + c * 8), b = *(const f32x4*)(x_in + c * 8 + 4);
            v4u o; o.x = pk2(a[0], a[1]); o.y = pk2(a[2], a[3]); o.z = pk2(b[0], b[1]); o.w = pk2(b[2], b[3]);
            *(v4u*)(ZB + c * 8) = o; }
    }
    __syncthreads();
    cg::this_grid().sync();

#define GRID_BAR() xcd_barrier(bar)
#pragma unroll 1
    for (int li_ = 0; li_ < DEPTH; ++li_) {
#pragma unroll 1
        for (int sub_ = 0; sub_ < 3; ++sub_) {
            int li = li_, sub = sub_; asm volatile("" : "+s"(li), "+s"(sub)); unsigned zv_; asm volatile("v_mov_b32 %0, 0" : "=v"(zv_)); int tidv = wave * 64 + (int)__builtin_amdgcn_mbcnt_hi(~0u, __builtin_amdgcn_mbcnt_lo(~0u, zv_)); asm volatile("" : "+v"(tidv));
            const int s = 3 * li + sub;
            const float* stat_in = s > 0 ? STAT + (size_t)(s - 1) * M * 2 : nullptr;
            float* stat_out = STAT + (size_t)s * M * 2;
            const float* gin = ln_g + (s > 0 ? s - 1 : 0) * D; const float* bin = ln_b + (s > 0 ? s - 1 : 0) * D;
            const float* zin = s > 0 ? (const float*)zout : x_in;
            { LAS float* gbw = (LAS float*)(lds + GB_OFF); for (int c = tidv; c < D; c += NWAVES * 64) { gbw[c] = gin[c]; gbw[D + c] = bin[c]; } }
            __syncthreads();
            if (sub != 1) {
                const int f = 2 * li + (sub >> 1);
                { pg8::Gemm g{ZB, W1T + (size_t)f * 2 * FF * D, M, 2 * FF, D}; pg8::StaticOrder S; S.init(M, 2 * FF, G, bx);
                  pg8::EpiSwiglu E{HB, stat_in, CS + f * 2 * FF, BW + f * 2 * FF};
                  asm volatile("" : "+v"(tidv)); pg8::gemm_phase<pg8::EpiSwiglu, pg8::StaticOrder, true, true>(lds, tidv, g, S, E); }
                GRID_BAR();
                { pg8::Gemm g{HB, W2T + (size_t)f * D * FF, M, D, FF}; pg8::StaticOrder S; S.init(M, D, G, bx);
                  pg8::EpiResid E{zin, zout, ZB, stat_in, (const LAS float*)(lds + GB_OFF), stat_out, 0.5f};
                  asm volatile("" : "+v"(tidv)); pg8::gemm_phase<pg8::EpiResid, pg8::StaticOrder, true, true>(lds, tidv, g, S, E); }
                GRID_BAR();
            } else {
                { pg8::Gemm g{ZB, WQKVT + (size_t)li * 3 * D * D, M, 3 * D, D}; pg8::StaticOrder S; S.init(M, 3 * D, G, bx);
                  pg8::EpiQKV E{QB, (size_t)M * D, stat_in, CS + CSV_QKV + li * 3 * D, BW + CSV_QKV + li * 3 * D, 0.125f * 1.4426950408889634f};
                  asm volatile("" : "+v"(tidv)); pg8::gemm_phase<pg8::EpiQKV, pg8::StaticOrder, true, true>(lds, tidv, g, S, E); }
                GRID_BAR();
                asm volatile("" : "+v"(tidv));
                for (int vb = bx; vb < 256; vb += G) { const int grp = vb >> 1, e = vb & 1, b = grp >> 3, hp = grp & 7;
                    if ((li & 1) == 0) { for (int i = 0; i < 8; ++i) att::chunk_attn_unit(b, hp, 2 * i + e, QB, KB, VB, QB, rel, lds, tidv); }
                    else { for (int i = 0; i < 8; ++i) { const int k = 2 * (i >> 1) + e, qb = (i & 1) ? 15 - k : k; att::stick_attn_unit(b, hp, qb, QB, KB, VB, QB, lds, tidv); } } }
                GRID_BAR();
                { pg8::Gemm g{QB, WOT + (size_t)li * D * D, M, D, D}; pg8::StaticOrder S; S.init(M, D, G, bx);
                  pg8::EpiResid E{zin, zout, ZB, stat_in, (const LAS float*)(lds + GB_OFF), stat_out, 1.0f};
                  asm volatile("" : "+v"(tidv)); pg8::gemm_phase<pg8::EpiResid, pg8::StaticOrder, true, true>(lds, tidv, g, S, E); }
                GRID_BAR();
            }
        }
    }
    {
        unsigned zv2_; asm volatile("v_mov_b32 %0, 0" : "=v"(zv2_)); const int lane = (int)__builtin_amdgcn_mbcnt_hi(~0u, __builtin_amdgcn_mbcnt_lo(~0u, zv2_));
        const int gw = bx * NWAVES + wave, NGW = G * NWAVES; const float* gl = ln_g + 11 * D; const float* bl = ln_b + 11 * D;
        for (int m = gw; m < M; m += NGW) { f32x4* xr = (f32x4*)(zout + (size_t)m * D) + lane; f32x4 v[4]; float s = 0.f;
#pragma unroll
            for (int j = 0; j < 4; ++j) { v[j] = xr[64 * j]; s += (v[j][0] + v[j][1]) + (v[j][2] + v[j][3]); }
            const float mean = wave_sum(s) * (1.f / D); float s2 = 0.f;
#pragma unroll
            for (int j = 0; j < 4; ++j) { v[j] = v[j] - mean; s2 += (v[j][0] * v[j][0] + v[j][1] * v[j][1]) + (v[j][2] * v[j][2] + v[j][3] * v[j][3]); }
            const float rstd = 1.f / sqrtf(wave_sum(s2) * (1.f / D) + 1e-5f);
#pragma unroll
            for (int j = 0; j < 4; ++j) { const f32x4 gg = *((const f32x4*)gl + lane + 64 * j), bb = *((const f32x4*)bl + lane + 64 * j); xr[64 * j] = v[j] * rstd * gg + bb; } }
    }
}

extern "C" void kernel_launch(void* const* d_in, const int* in_sizes, int n_in, void* d_out, int out_size, void* d_ws, size_t ws_size, hipStream_t stream) {
    static int grid = 0;
    if (grid == 0) {
        if (n_in != 11 || ws_size < WS_END) { fprintf(stderr, "kernel_launch: unexpected inputs (n_in %d, ws %zu)\n", n_in, ws_size); grid = -1; return; }
        int dev = 0, cus = 0, per_cu = 0;
        (void)hipGetDevice(&dev); (void)hipDeviceGetAttribute(&cus, hipDeviceAttributeMultiprocessorCount, dev);
        (void)hipFuncSetAttribute((const void*)fwd_megakernel, hipFuncAttributeMaxDynamicSharedMemorySize, LDS_BYTES);
        if (hipOccupancyMaxActiveBlocksPerMultiprocessor(&per_cu, (const void*)fwd_megakernel, NWAVES * 64, LDS_BYTES) != hipSuccess || per_cu < 1) { fprintf(stderr, "kernel_launch: occupancy query says %d\n", per_cu); per_cu = 1; }
        (void)hipGetLastError();
        grid = cus;
        if (grid > 256) grid = 256;
    }
    if (grid < 0) return;
    (void)hipMemsetAsync((char*)d_ws + WS_CTL, 0, CTL_ZERO_BYTES, stream);
    Args a{};
    for (int i = 0; i < 11; ++i) a.in[i] = (const float*)d_in[i];
    a.out = (float*)d_out; a.ws = (unsigned char*)d_ws;
    void* kargs[] = {&a};
    hipError_t e = hipLaunchCooperativeKernel((const void*)fwd_megakernel, dim3(grid), dim3(NWAVES * 64), kargs, LDS_BYTES, stream);
    if (e != hipSuccess) fprintf(stderr, "cooperative launch failed: %s (grid %d)\n", hipGetErrorString(e), grid);
}
```

```cpp
#include <hip/hip_runtime.h>
#include <hip/hip_cooperative_groups.h>
#include <cstdio>
#include <cstdint>
namespace cg = cooperative_groups;
namespace pg8 {
#define PG8_LAS __attribute__((address_space(3)))
typedef unsigned short bf16_t;
typedef short bf16x8 __attribute__((ext_vector_type(8)));
typedef float f32x4 __attribute__((ext_vector_type(4)));
typedef unsigned u32x4 __attribute__((ext_vector_type(4)));
constexpr int BM = 256, BK = 64, HALF = 128, HTB = HALF * BK * 2  , STAGE_BYTES = 8 * HTB, NXCD = 8, WGM = 8;

__host__ __device__ __forceinline__ int lds_byte(int r, int c) { const int st = (r >> 4) * 2 + (c >> 5), rr = r & 15, cc = c & 31, ob = rr * 64 + cc * 2; return st * 1024 + (ob ^ (((ob >> 9) & 1) << 5)); }
__host__ __device__ __forceinline__ void stage_rc(int b, int& R, int& C) { const int st = b / 1024, sb = b % 1024, swz = sb ^ (((sb >> 9) & 1) << 5); R = (st >> 1) * 16 + swz / 64; C = (st & 1) * 32 + (swz % 64) / 2; }
__host__ __device__ __forceinline__ int perm32(int rho) { const int n = rho >> 4, i = rho & 15; return 8 * (i >> 2) + 4 * n + (i & 3); }

struct Unit { int pm, pn; };
struct Gemm { const bf16_t* A; const bf16_t* Bt; int M, N, K; };

struct StaticOrder {
    int nM, nN, nwg, G, c, rev;
    __host__ __device__ void init(int M, int N, int G_, int c_, int rev_ = 0) { nM = M / BM; nN = N / BM; nwg = nM * nN; G = G_; c = c_; rev = (rev_ && nwg % G_ == 0) ? nwg / G_ : 0; }
    __host__ __device__ bool next(int i, Unit& u) const {
        const long L = (long)(rev ? rev - 1 - i : i) * G + c; if (L >= nwg || L < 0) return false;
        int wgid = (int)L; { const int q = nwg / NXCD, r = nwg % NXCD, xcd = wgid % NXCD, off = wgid / NXCD; wgid = (xcd < r ? xcd * (q + 1) : r * (q + 1) + (xcd - r) * q) + off; }
        const int nig = WGM * nN, gid = wgid / nig, fm = gid * WGM, gsz = (nM - fm) < WGM ? (nM - fm) : WGM;
        u.pm = fm + ((wgid % nig) % gsz); u.pn = (wgid % nig) / gsz; return true;
    }
    __device__ __forceinline__ void a_ready(const Unit&) const {}
    __device__ __forceinline__ void done(const Unit&) const {}
};

struct ListOrder {
    const PG8_LAS int* list; int count;
    __device__ __forceinline__ bool next(int i, Unit& u) const { if (i >= count) return false; u.pm = __builtin_amdgcn_readfirstlane(list[2 * i]); u.pn = __builtin_amdgcn_readfirstlane(list[2 * i + 1]); return true; }
    __device__ __forceinline__ void a_ready(const Unit&) const {}
    __device__ __forceinline__ void done(const Unit&) const {}
};
__device__ __forceinline__ ListOrder make_list(const StaticOrder& S, PG8_LAS int* lst, int tid) {
    int cnt = 0; if (S.c < S.nwg) cnt = (S.nwg - S.c + S.G - 1) / S.G; if (cnt > 128) cnt = 128;
    if (tid < cnt) { Unit u; u.pm = 0; u.pn = 0; (void)S.next(tid, u); lst[2 * tid] = u.pm; lst[2 * tid + 1] = u.pn; }
    __syncthreads();
    ListOrder L; L.list = lst; L.count = cnt; return L;
}

__device__ __forceinline__ unsigned cvt_pk_bf16(float lo, float hi) { unsigned r; asm volatile("v_cvt_pk_bf16_f32 %0, %1, %2" : "=v"(r) : "v"(lo), "v"(hi)); return r; }
typedef float f32x2 __attribute__((ext_vector_type(2)));
typedef _Float16 f16x8 __attribute__((ext_vector_type(8)));
template <bool F16> __device__ __forceinline__ f32x4 mma16(bf16x8 a, bf16x8 b, f32x4 c) {
    if constexpr (F16) return __builtin_amdgcn_mfma_f32_16x16x32_f16(__builtin_bit_cast(f16x8, a), __builtin_bit_cast(f16x8, b), c, 0, 0, 0);
    else return __builtin_amdgcn_mfma_f32_16x16x32_bf16(a, b, c, 0, 0, 0);
}
__device__ __forceinline__ float ld_agent_f32(const float* p) { return __hip_atomic_load(p, __ATOMIC_RELAXED, __HIP_MEMORY_SCOPE_AGENT); }
typedef unsigned u32x2 __attribute__((ext_vector_type(2)));
__device__ __forceinline__ void row_stats8(const float* st, int row0, float (&mu)[2][4], float (&rs)[2][4]) {
#pragma unroll
    for (int ai = 0; ai < 2; ++ai)
#pragma unroll
        for (int m = 0; m < 4; ++m) { if (st) { const int row = row0 + ai * HALF + m * 16; const f32x2 sq = *(const f32x2*)(st + 2 * row);
            const float mm = sq[0] * (1.0f / 1024.0f), var = fmaxf(sq[1] * (1.0f / 1024.0f) - mm * mm, 0.f); mu[ai][m] = mm; rs[ai][m] = __builtin_amdgcn_rsqf(var + 1e-5f); } else { mu[ai][m] = 0.f; rs[ai][m] = 1.f; } }
}
__device__ __forceinline__ void stash_unit(const Unit& u, int wid, int lane, const float* cs, const float* bw, const float* stat, PG8_LAS float* st) {
    const float* src = (wid < 4 ? cs : bw) + u.pn * BM + (wid & 3) * 64 + lane;
    __builtin_amdgcn_global_load_lds((const unsigned*)src, (PG8_LAS unsigned*)(st + wid * 64), 4, 0, 0);
    __builtin_amdgcn_global_load_lds((const unsigned*)(stat + 2 * (size_t)(u.pm * BM) + wid * 64 + lane), (PG8_LAS unsigned*)(st + 512 + wid * 64), 4, 0, 0);
}
__device__ __forceinline__ void row_stats8_lds(const PG8_LAS float* st, int rl0, float (&mu)[2][4], float (&rs)[2][4]) {
#pragma unroll
    for (int ai = 0; ai < 2; ++ai)
#pragma unroll
        for (int m = 0; m < 4; ++m) { const f32x2 sq = *(const PG8_LAS f32x2*)(st + 512 + 2 * (rl0 + ai * HALF + m * 16));
            const float mm = sq[0] * (1.0f / 1024.0f), var = fmaxf(sq[1] * (1.0f / 1024.0f) - mm * mm, 0.f); mu[ai][m] = mm; rs[ai][m] = __builtin_amdgcn_rsqf(var + 1e-5f); }
}
struct EpiSwiglu {
    static constexpr bool PERM = true, AFTER_DRAIN = false, STASH = true;
    bf16_t* H; const float* stat; const float* cs; const float* bw; PG8_LAS float* st;
    __device__ __forceinline__ void stash(const Unit& u, int wid, int lane) const { stash_unit(u, wid, lane, cs, bw, stat, st); }
    __device__ __forceinline__ void operator()(const f32x4 (&acc)[2][2][4][2], const Unit& u, int wr, int wc, int fr, int fq) const {
        const int row0 = u.pm * BM + wr * 64 + fr; const int cc = u.pn * BM + wc * 32 + 8 * fq; const int hc = u.pn * HALF + wc * 32 + 8 * fq;
        float mu[2][4], rs[2][4]; row_stats8_lds(st, wr * 64 + fr, mu, rs);
        const int lc = wc * 32 + 8 * fq;
        f32x4 csg[2], csu[2], bwg[2], bwu[2];
#pragma unroll
        for (int n = 0; n < 2; ++n) { csg[n] = *(const PG8_LAS f32x4*)(st + lc + 4 * n); csu[n] = *(const PG8_LAS f32x4*)(st + lc + HALF + 4 * n); bwg[n] = *(const PG8_LAS f32x4*)(st + 256 + lc + 4 * n); bwu[n] = *(const PG8_LAS f32x4*)(st + 256 + lc + HALF + 4 * n); }
#pragma unroll
        for (int ai = 0; ai < 2; ++ai)
#pragma unroll
            for (int m = 0; m < 4; ++m) { const int row = row0 + ai * HALF + m * 16; f32x4 hv[2];
#pragma unroll
                for (int n = 0; n < 2; ++n) { const f32x4 g = (acc[ai][0][m][n] - csg[n] * mu[ai][m]) * rs[ai][m] + bwg[n], up = (acc[ai][1][m][n] - csu[n] * mu[ai][m]) * rs[ai][m] + bwu[n];
                    const f32x4 t = g * -1.4426950408889634f; f32x4 e = (f32x4){__builtin_amdgcn_exp2f(t[0]), __builtin_amdgcn_exp2f(t[1]), __builtin_amdgcn_exp2f(t[2]), __builtin_amdgcn_exp2f(t[3])};
                    e = e + 1.0f; const f32x4 r = (f32x4){__builtin_amdgcn_rcpf(e[0]), __builtin_amdgcn_rcpf(e[1]), __builtin_amdgcn_rcpf(e[2]), __builtin_amdgcn_rcpf(e[3])};
                    hv[n] = (g * up) * r; }
                u32x4 w; w.x = cvt_pk_bf16(hv[0][0], hv[0][1]); w.y = cvt_pk_bf16(hv[0][2], hv[0][3]); w.z = cvt_pk_bf16(hv[1][0], hv[1][1]); w.w = cvt_pk_bf16(hv[1][2], hv[1][3]);
                *(u32x4*)(H + (size_t)row * 2816 + hc) = w; }
    }
};
struct EpiQKV {
    static constexpr bool PERM = true, AFTER_DRAIN = false, STASH = true;
    bf16_t* Q; size_t tstride; const float* stat; const float* cs; const float* bw; float qscale; PG8_LAS float* st;
    __device__ __forceinline__ void stash(const Unit& u, int wid, int lane) const { stash_unit(u, wid, lane, cs, bw, stat, st); }
    __device__ __forceinline__ void operator()(const f32x4 (&acc)[2][2][4][2], const Unit& u, int wr, int wc, int fr, int fq) const {
        const int row0 = u.pm * BM + wr * 64 + fr; const int cc = u.pn * BM + wc * 32 + 8 * fq;
        const int t = (u.pn * BM) >> 10; bf16_t* base = Q + (size_t)t * tstride; const int col0 = ((u.pn * BM) & 1023) + wc * 32 + 8 * fq; const float sc = (t == 0) ? qscale : 1.0f;
        float mu[2][4], rs[2][4]; row_stats8_lds(st, wr * 64 + fr, mu, rs);
        const int lc = wc * 32 + 8 * fq;
#pragma unroll
        for (int bj = 0; bj < 2; ++bj) { const f32x4 cs0 = *(const PG8_LAS f32x4*)(st + lc + bj * HALF), cs1 = *(const PG8_LAS f32x4*)(st + lc + bj * HALF + 4), bw0 = *(const PG8_LAS f32x4*)(st + 256 + lc + bj * HALF), bw1 = *(const PG8_LAS f32x4*)(st + 256 + lc + bj * HALF + 4);
#pragma unroll
            for (int ai = 0; ai < 2; ++ai)
#pragma unroll
                for (int m = 0; m < 4; ++m) { const int row = row0 + ai * HALF + m * 16;
                    const f32x4 v0 = ((acc[ai][bj][m][0] - cs0 * mu[ai][m]) * rs[ai][m] + bw0) * sc, v1 = ((acc[ai][bj][m][1] - cs1 * mu[ai][m]) * rs[ai][m] + bw1) * sc;
                    u32x4 w; w.x = cvt_pk_bf16(v0[0], v0[1]); w.y = cvt_pk_bf16(v0[2], v0[3]); w.z = cvt_pk_bf16(v1[0], v1[1]); w.w = cvt_pk_bf16(v1[2], v1[3]);
                    *(u32x4*)(base + (size_t)row * 1024 + col0 + bj * HALF) = w; } }
    }
};
struct EpiResid {
    static constexpr bool PERM = true, AFTER_DRAIN = false, STASH = false;
    _Float16* z; const float* stat_in; const PG8_LAS float* gb; float* stat_out; float coef;
    __device__ __forceinline__ void operator()(const f32x4 (&acc)[2][2][4][2], const Unit& u, int wr, int wc, int fr, int fq) const {
        constexpr float ALPHA = 1.681792830507429f;
        const int row0 = u.pm * BM + wr * 64 + fr; const int col0 = u.pn * BM + wc * 32 + 8 * fq;
#pragma unroll
        for (int ai = 0; ai < 2; ++ai) {
            f32x2 sq[4]; f16x8 hh[4][2];
#pragma unroll
            for (int m = 0; m < 4; ++m) { sq[m] = *(const f32x2*)(stat_in + 2 * (row0 + ai * HALF + m * 16));
#pragma unroll
                for (int bj = 0; bj < 2; ++bj) hh[m][bj] = *(const f16x8*)(z + (unsigned)(row0 + ai * HALF + m * 16) * 1024u + (unsigned)col0 + bj * HALF); }
            float tprev = 0.f;
#pragma unroll
            for (int m = 0; m < 4; ++m) { const int row = row0 + ai * HALF + m * 16; const unsigned off = (unsigned)row * 1024u + (unsigned)col0;
                const f16x8 (&h)[2] = hh[m];
                const float mu = sq[m][0] * (1.0f / 1024.0f), var = fmaxf(sq[m][1] * (1.0f / 1024.0f) - mu * mu, 0.f), rs = __builtin_amdgcn_rsqf(var + 1e-5f);
                float s = 0.f, q = 0.f;
#pragma unroll
                for (int bj = 0; bj < 2; ++bj) { f32x4 zn[2];
#pragma unroll
                    for (int n = 0; n < 2; ++n) { const f32x4 zr = (f32x4){(float)h[bj][4 * n], (float)h[bj][4 * n + 1], (float)h[bj][4 * n + 2], (float)h[bj][4 * n + 3]};
                        const f32x4 gv = *(const PG8_LAS f32x4*)(gb + col0 + bj * HALF + 4 * n), bv = *(const PG8_LAS f32x4*)(gb + 1024 + col0 + bj * HALF + 4 * n);
                        const f32x4 xn = (zr - mu) * rs * gv + bv;
                        zn[n] = xn * ALPHA + acc[ai][bj][m][n] * coef;
                        s += (zn[n][0] + zn[n][1]) + (zn[n][2] + zn[n][3]); q += (zn[n][0] * zn[n][0] + zn[n][1] * zn[n][1]) + (zn[n][2] * zn[n][2] + zn[n][3] * zn[n][3]); }
                    const f16x8 w = (f16x8){(_Float16)zn[0][0], (_Float16)zn[0][1], (_Float16)zn[0][2], (_Float16)zn[0][3], (_Float16)zn[1][0], (_Float16)zn[1][1], (_Float16)zn[1][2], (_Float16)zn[1][3]};
                    *(f16x8*)(z + off + bj * HALF) = w; }
                const bool odd = (fq & 1) != 0; float t = odd ? q : s; const float u = odd ? s : q;
                t += __shfl_xor(u, 16); t += __shfl_xor(t, 32);
                if (m & 1) { const int arow = row0 + ai * HALF + (m - 1 + (fq >> 1)) * 16; unsafeAtomicAdd(stat_out + 2 * arow + (fq & 1), (fq >> 1) ? t : tprev); }
                tprev = t; }
            asm volatile("" ::: "memory"); }
    }
};

template <class Epi, class Sched, bool ALIGN_EPI = false, bool SP2 = false, bool F16 = false>
__device__ __forceinline__ void gemm_phase(PG8_LAS unsigned char* lds, const int tid, const Gemm g, const Sched& S, const Epi& E) {
    const int  wid = __builtin_amdgcn_readfirstlane(tid >> 6), lane = tid & 63, wr = wid >> 2, wc = wid & 3, fr = lane & 15, fq = lane >> 4;
    const int K = g.K, nt = K / BK;
    unsigned voffA[2], voffB[2];
#pragma unroll
    for (int i = 0; i < 2; ++i) { int R, C; stage_rc(tid * 16 + i * 8192, R, C); const int Rb = Epi::PERM ? ((R & ~31) + perm32(R & 31)) : R;
        voffA[i] = (unsigned)(R * K + C) * 2u; voffB[i] = (unsigned)(Rb * K + C) * 2u; }
    const size_t kstep = (size_t)(BK * 2);
    const size_t hstep = (size_t)HALF * K * 2;
    const size_t tstep = 2 * hstep;
    const unsigned ldsw = (unsigned)wid * 1024u;
    const int aoff = lds_byte(wr * 64 + fr, fq * 8), boff = lds_byte(wc * 32 + fr, fq * 8);
#define PG8_SA(b, h) (((b) * 2 + (h)) * HTB)
#define PG8_SB(b, h) ((4 + (b) * 2 + (h)) * HTB)
#define PG8_STAGE(bufoff, gbase, voff) do { _Pragma("unroll") for (int _i = 0; _i < 2; ++_i) \
        __builtin_amdgcn_global_load_lds((const unsigned*)((const char*)(gbase) + (voff)[_i]), (PG8_LAS unsigned*)(lds + (bufoff) + ldsw + _i * 8192), 16, 0, 0); } while (0)
#define PG8_LDA(dst, b, h) do { _Pragma("unroll") for (int m = 0; m < 4; ++m) _Pragma("unroll") for (int k = 0; k < 2; ++k) dst[m][k] = *(const PG8_LAS bf16x8*)(lds + PG8_SA(b, h) + aoff + m * 2048 + k * 1024); } while (0)
#define PG8_LDB(dst, b, h) do { _Pragma("unroll") for (int n = 0; n < 2; ++n) _Pragma("unroll") for (int k = 0; k < 2; ++k) dst[n][k] = *(const PG8_LAS bf16x8*)(lds + PG8_SB(b, h) + boff + n * 2048 + k * 1024); } while (0)
#define PG8_MMA(ai, bj, At, Bt) do { __builtin_amdgcn_s_setprio(1); _Pragma("unroll") for (int m = 0; m < 4; ++m) _Pragma("unroll") for (int n = 0; n < 2; ++n) _Pragma("unroll") for (int k = 0; k < 2; ++k) \
        acc[ai][bj][m][n] = mma16<F16>(Bt[n][k], At[m][k], acc[ai][bj][m][n]); __builtin_amdgcn_s_setprio(0); } while (0)
#define PG8_WAIT_V(n) asm volatile("s_waitcnt vmcnt(" #n ")" ::: "memory")
#define PG8_WAIT_L(n) asm volatile("s_waitcnt lgkmcnt(" #n ")" ::: "memory")
#define PG8_BAR __builtin_amdgcn_s_barrier()
#define PG8_SCHED __builtin_amdgcn_sched_barrier(0)
    Unit cur, nxt; int ui = 0;
    if (!S.next(0, cur)) return;
    f32x4 acc[2][2][4][2];
#pragma unroll
    for (int a = 0; a < 2; ++a)
#pragma unroll
        for (int b = 0; b < 2; ++b)
#pragma unroll
            for (int m = 0; m < 4; ++m)
#pragma unroll
                for (int n = 0; n < 2; ++n) acc[a][b][m][n] = (f32x4){0.f, 0.f, 0.f, 0.f};
    bf16x8 At[4][2], B0[2][2], B1[2][2];
    const char* cA = (const char*)g.A + (size_t)cur.pm * tstep; const char* cB = (const char*)g.Bt + (size_t)cur.pn * tstep;
    S.a_ready(cur);
    if constexpr (SP2) {
        PG8_STAGE(PG8_SB(0, 0), cB, voffB); PG8_STAGE(PG8_SB(0, 1), cB + hstep, voffB); PG8_STAGE(PG8_SA(0, 0), cA, voffA); PG8_STAGE(PG8_SA(0, 1), cA + hstep, voffA);
        if (wr == 1) PG8_BAR;
        PG8_WAIT_V(2); PG8_BAR;
        PG8_STAGE(PG8_SB(1, 0), cB + kstep, voffB); PG8_STAGE(PG8_SA(1, 0), cA + kstep, voffA); PG8_STAGE(PG8_SB(1, 1), cB + hstep + kstep, voffB);
        PG8_WAIT_V(6); PG8_BAR;
    } else {
        PG8_STAGE(PG8_SB(0, 0), cB, voffB); PG8_STAGE(PG8_SA(0, 0), cA, voffA); PG8_STAGE(PG8_SB(0, 1), cB + hstep, voffB); PG8_STAGE(PG8_SA(0, 1), cA + hstep, voffA);
        if (wr == 1) PG8_BAR;
        PG8_WAIT_V(4); PG8_BAR;
        PG8_STAGE(PG8_SB(1, 0), cB + kstep, voffB); PG8_STAGE(PG8_SA(1, 0), cA + kstep, voffA); PG8_STAGE(PG8_SB(1, 1), cB + hstep + kstep, voffB);
        PG8_WAIT_V(6); PG8_BAR;
    }
    for (;;) {
        const bool has_next = S.next(ui + 1, nxt);
        const char* nA = has_next ? (const char*)g.A + (size_t)nxt.pm * tstep : cA; const char* nB = has_next ? (const char*)g.Bt + (size_t)nxt.pn * tstep : cB;
        for (int t = 0; t < nt; t += 2) {
            const bool last = (t == nt - 2);
            const char* a1 = cA + (size_t)(t + 1) * kstep;
            const char* a2 = last ? nA : cA + (size_t)(t + 2) * kstep; const char* b2 = last ? nB : cB + (size_t)(t + 2) * kstep;
            const char* a3 = a2 + kstep; const char* b3 = b2 + kstep;
            if (last && has_next) S.a_ready(nxt);
            if constexpr (Epi::STASH) { if (last) E.stash(cur, wid, lane); }
            if constexpr (SP2) {
            PG8_LDB(B0, 0, 0); PG8_LDB(B1, 0, 1); PG8_SCHED; PG8_LDA(At, 0, 0); PG8_STAGE(PG8_SA(1, 1), a1 + hstep, voffA);
            PG8_WAIT_V(8); PG8_WAIT_L(0); PG8_BAR; PG8_MMA(0, 0, At, B0); PG8_MMA(0, 1, At, B1); PG8_BAR; PG8_SCHED;
            PG8_LDA(At, 0, 1); PG8_STAGE(PG8_SB(0, 0), b2, voffB); PG8_STAGE(PG8_SB(0, 1), b2 + hstep, voffB); PG8_STAGE(PG8_SA(0, 0), a2, voffA);
            PG8_WAIT_V(8); PG8_WAIT_L(0); PG8_BAR; PG8_MMA(1, 0, At, B0); PG8_MMA(1, 1, At, B1); PG8_BAR; PG8_SCHED;
            PG8_LDB(B0, 1, 0); PG8_LDB(B1, 1, 1); PG8_SCHED; PG8_LDA(At, 1, 0); PG8_STAGE(PG8_SA(0, 1), a2 + hstep, voffA);
            PG8_WAIT_V(8); PG8_WAIT_L(0); PG8_BAR; PG8_MMA(0, 0, At, B0); PG8_MMA(0, 1, At, B1); PG8_BAR; PG8_SCHED;
            PG8_LDA(At, 1, 1); PG8_STAGE(PG8_SB(1, 0), b3, voffB); PG8_STAGE(PG8_SB(1, 1), b3 + hstep, voffB); PG8_STAGE(PG8_SA(1, 0), a3, voffA);
            PG8_WAIT_V(8); PG8_WAIT_L(0); PG8_BAR; PG8_MMA(1, 0, At, B0); PG8_MMA(1, 1, At, B1); PG8_BAR; PG8_SCHED;
            } else {
            PG8_LDB(B0, 0, 0); PG8_SCHED; PG8_LDA(At, 0, 0); PG8_STAGE(PG8_SA(1, 1), a1 + hstep, voffA);
            PG8_WAIT_L(8); PG8_BAR; PG8_WAIT_L(0); PG8_MMA(0, 0, At, B0); PG8_BAR; PG8_SCHED;
            PG8_LDB(B1, 0, 1); PG8_STAGE(PG8_SB(0, 0), b2, voffB);
            PG8_BAR; PG8_WAIT_L(0); PG8_MMA(0, 1, At, B1); PG8_BAR;
            PG8_LDA(At, 0, 1); PG8_STAGE(PG8_SA(0, 0), a2, voffA);
            PG8_BAR; PG8_WAIT_L(0); PG8_MMA(1, 0, At, B0); PG8_BAR; PG8_SCHED;
            PG8_STAGE(PG8_SB(0, 1), b2 + hstep, voffB);
            PG8_WAIT_V(6); PG8_BAR; PG8_MMA(1, 1, At, B1); PG8_BAR;
            PG8_LDB(B0, 1, 0); PG8_SCHED; PG8_LDA(At, 1, 0); PG8_STAGE(PG8_SA(0, 1), a2 + hstep, voffA);
            PG8_WAIT_L(8); PG8_BAR; PG8_WAIT_L(0); PG8_MMA(0, 0, At, B0); PG8_BAR; PG8_SCHED;
            PG8_LDB(B1, 1, 1); PG8_STAGE(PG8_SB(1, 0), b3, voffB);
            PG8_BAR; PG8_WAIT_L(0); PG8_MMA(0, 1, At, B1); PG8_BAR;
            PG8_LDA(At, 1, 1); PG8_STAGE(PG8_SA(1, 0), a3, voffA);
            PG8_BAR; PG8_WAIT_L(0); PG8_MMA(1, 0, At, B0); PG8_BAR; PG8_SCHED;
            PG8_STAGE(PG8_SB(1, 1), b3 + hstep, voffB);
            PG8_WAIT_V(6); PG8_BAR; PG8_MMA(1, 1, At, B1); PG8_BAR;
            }
        }
        if constexpr (ALIGN_EPI) { if (wr == 0) PG8_BAR; }
        if constexpr (!Epi::AFTER_DRAIN) { E(acc, cur, wr, wc, fr, fq); S.done(cur); }
        if (!has_next) break;
#pragma unroll
        for (int a = 0; a < 2; ++a)
#pragma unroll
            for (int b = 0; b < 2; ++b)
#pragma unroll
                for (int m = 0; m < 4; ++m)
#pragma unroll
                    for (int n = 0; n < 2; ++n) acc[a][b][m][n] = (f32x4){0.f, 0.f, 0.f, 0.f};
        cur = nxt; cA = nA; cB = nB; ++ui;
        if constexpr (ALIGN_EPI) { if (wr == 1) PG8_BAR; }
    }
    PG8_WAIT_V(0);
    if constexpr (!ALIGN_EPI) { if (wr == 0) PG8_BAR; }
    PG8_BAR;
    if constexpr (Epi::AFTER_DRAIN) { E.fused(acc, cur, wr, wc, fr, fq, lds, wid, lane); S.done(cur); }
#undef PG8_SA
#undef PG8_SB
#undef PG8_STAGE
#undef PG8_LDA
#undef PG8_LDB
#undef PG8_MMA
#undef PG8_WAIT_V
#undef PG8_WAIT_L
#undef PG8_BAR
#undef PG8_SCHED
}
}
namespace att {
#define ALAS __attribute__((address_space(3)))
typedef unsigned short bf16_t;
typedef short bf16x8 __attribute__((ext_vector_type(8)));
typedef short s16x4 __attribute__((ext_vector_type(4)));
typedef float f32x16 __attribute__((ext_vector_type(16)));
typedef unsigned u32x4 __attribute__((ext_vector_type(4)));
constexpr int DM = 1024, SEQ = 2048;
constexpr int VHALF = 4096;
constexpr int L_KV = 0;
constexpr int L_WSF = 65536;
constexpr int L_TAB = 65536 + 2048;
constexpr int L_OST = 65536 + 8192;
constexpr int L_FLAG = L_OST + 32768;
constexpr float LOG2E = 1.4426950408889634f;
__device__ __forceinline__ int crow(int r, int hi) { return (r & 3) + 8 * (r >> 2) + 4 * hi; }
__device__ __forceinline__ unsigned cvtpk(float lo, float hi) { unsigned r; asm volatile("v_cvt_pk_bf16_f32 %0, %1, %2" : "=v"(r) : "v"(lo), "v"(hi)); return r; }
typedef short v4i16_t __attribute__((ext_vector_type(4)));
__device__ __forceinline__ s16x4 vtr(const ALAS unsigned char* p) { return __builtin_bit_cast(s16x4, __builtin_amdgcn_ds_read_tr16_b64_v4i16((ALAS v4i16_t*)p)); }

struct Stage { u32x4 k[2], v[2]; };
__device__ __forceinline__ void stage_load(Stage& s, const bf16_t* Kg, const bf16_t* Vg, long tok0, int hcol, int t256) {
#pragma unroll
    for (int i = 0; i < 2; ++i) { const int cid = t256 + 256 * i, row = cid >> 3, ch = cid & 7; const size_t o = (size_t)(tok0 + row) * DM + hcol + ch * 8;
        s.k[i] = *(const u32x4*)(Kg + o); s.v[i] = *(const u32x4*)(Vg + o); }
}
__device__ __forceinline__ void stage_store(const Stage& s, ALAS unsigned char* kbuf, ALAS unsigned char* vbuf, int t256) {
#pragma unroll
    for (int i = 0; i < 2; ++i) { const int cid = t256 + 256 * i, row = cid >> 3, ch = cid & 7;
        *(ALAS u32x4*)(kbuf + row * 128 + ((ch ^ ((row >> 1) & 7)) << 4)) = s.k[i];
        *(ALAS u32x4*)(vbuf + (ch >> 2) * VHALF + row * 64 + (ch & 3) * 16) = s.v[i]; }
}
__device__ __forceinline__ void qk_tile(f32x16& p0, f32x16& p1, const ALAS unsigned char* kbuf, const bf16x8 (&qr)[4], int r32, int hi, const f32x16& cinit) {
    const int sw = (r32 >> 1) & 7;
#pragma unroll
    for (int d0 = 0; d0 < 4; ++d0) { const int ch = 2 * d0 + hi;
        const bf16x8 a0 = *(const ALAS bf16x8*)(kbuf + r32 * 128 + ((ch ^ sw) << 4));
        const bf16x8 a1 = *(const ALAS bf16x8*)(kbuf + (r32 + 32) * 128 + ((ch ^ sw) << 4));
        p0 = __builtin_amdgcn_mfma_f32_32x32x16_bf16(a0, qr[d0], d0 == 0 ? cinit : p0, 0, 0, 0);
        p1 = __builtin_amdgcn_mfma_f32_32x32x16_bf16(a1, qr[d0], d0 == 0 ? cinit : p1, 0, 0, 0); }
}
__device__ __forceinline__ float max3f(float a, float b, float c) { float r; asm("v_max3_f32 %0, %1, %2, %3" : "=v"(r) : "v"(a), "v"(b), "v"(c)); return r; }
__device__ __forceinline__ void pv_tile(f32x16 (&o)[2], const ALAS unsigned char* vbuf, const f32x16& p0, const f32x16& p1, int lane, int hi) {
    u32x4 pw[4];
#pragma unroll
    for (int k = 0; k < 2; ++k) { pw[k] = (u32x4){cvtpk(p0[8 * k + 0], p0[8 * k + 1]), cvtpk(p0[8 * k + 2], p0[8 * k + 3]), cvtpk(p0[8 * k + 4], p0[8 * k + 5]), cvtpk(p0[8 * k + 6], p0[8 * k + 7])};
        pw[2 + k] = (u32x4){cvtpk(p1[8 * k + 0], p1[8 * k + 1]), cvtpk(p1[8 * k + 2], p1[8 * k + 3]), cvtpk(p1[8 * k + 4], p1[8 * k + 5]), cvtpk(p1[8 * k + 6], p1[8 * k + 7])}; }
    const ALAS unsigned char* vp = vbuf + ((lane >> 4) & 1) * 32 + (lane & 3) * 8 + (4 * hi + ((lane & 15) >> 2)) * 64;
#pragma unroll
    for (int d0 = 0; d0 < 2; ++d0)
#pragma unroll
        for (int ks = 0; ks < 4; ++ks) { const s16x4 lo = vtr(vp + d0 * VHALF + ks * 1024), hh = vtr(vp + d0 * VHALF + ks * 1024 + 512);
            const bf16x8 vb = (bf16x8){lo[0], lo[1], lo[2], lo[3], hh[0], hh[1], hh[2], hh[3]};
            o[d0] = __builtin_amdgcn_mfma_f32_32x32x16_bf16(__builtin_bit_cast(bf16x8, pw[ks]), vb, o[d0], 0, 0, 0); }
}
__device__ __forceinline__ void store_o(const f32x16 (&o)[2], ALAS unsigned char* lds, int wid, int lane, int r32, int hi, bf16_t* Og  , bool scaled) {
    ALAS float* wsf = (ALAS float*)(lds + L_WSF) + wid * 64;
    ALAS bf16_t* stg = (ALAS bf16_t*)(lds + L_OST) + wid * 2048;
#pragma unroll
    for (int r = 0; r < 16; ++r) { const int orow = crow(r, hi); const float sc = scaled ? wsf[orow] : 1.0f;
#pragma unroll
        for (int d0 = 0; d0 < 2; ++d0) { const unsigned w = cvtpk(o[d0][r] * sc, 0.f); stg[orow * 64 + d0 * 32 + r32] = (bf16_t)(w & 0xffffu); } }
    asm volatile("s_waitcnt lgkmcnt(0)" ::: "memory");
#pragma unroll
    for (int i = 0; i < 4; ++i) { const int row = i * 8 + (lane >> 3), ch = lane & 7; const u32x4 v = *(const ALAS u32x4*)(stg + row * 64 + ch * 8); *(u32x4*)(Og + (size_t)row * DM + ch * 8) = v; }
    asm volatile("s_waitcnt lgkmcnt(0)" ::: "memory");
}

__device__ __forceinline__ void chunk_prefetch(int b, int hp, int qblk, const bf16_t* Q, const bf16_t* K, const bf16_t* V, bf16x8 (&qn)[4], Stage& Sn, const int tid) {
    const int lane = tid & 63, r32 = lane & 31, hi = lane >> 5, wid = __builtin_amdgcn_readfirstlane(tid >> 6), half = wid >> 2, w4 = wid & 3, t256 = tid & 255;
    const int hcol = (2 * hp + half) * 64; const long tokb = (long)b * SEQ;
    const int cq = 2 * qblk + (w4 >> 1), tq0 = cq * 64 + (w4 & 1) * 32, kc_lo = (2 * qblk - 8) > 0 ? (2 * qblk - 8) : 0;
#pragma unroll
    for (int d0 = 0; d0 < 4; ++d0) qn[d0] = *(const bf16x8*)(Q + (size_t)(tokb + tq0 + r32) * DM + hcol + d0 * 16 + hi * 8);
    stage_load(Sn, K, V, tokb + (long)kc_lo * 64, hcol, t256);
}
__device__ __forceinline__ void chunk_attn_unit(int b, int hp, int qblk, int qblk_next, bf16x8 (&qn)[4], Stage& Sn, const bf16_t* Q, const bf16_t* K, const bf16_t* V, bf16_t* O, const float* rel, ALAS unsigned char* lds, const int tid) {
    const int lane = tid & 63, r32 = lane & 31, hi = lane >> 5, wid = __builtin_amdgcn_readfirstlane(tid >> 6), half = wid >> 2, w4 = wid & 3, t256 = tid & 255;
    const int h = 2 * hp + half, hcol = h * 64; const long tokb = (long)b * SEQ;
    const int cq = 2 * qblk + (w4 >> 1), iq0 = (w4 & 1) * 32, tq0 = cq * 64 + iq0;
    ALAS float* wsf = (ALAS float*)(lds + L_WSF) + wid * 64;
    ALAS float* tab = (ALAS float*)(lds + L_TAB) + half * 260;
    bf16x8 qr[4];
#pragma unroll
    for (int d0 = 0; d0 < 4; ++d0) qr[d0] = qn[d0];
    for (int i = t256; i < 257; i += 256) tab[i] = rel[i * 16 + h] * LOG2E;
    const int kc_lo = (2 * qblk - 8) > 0 ? (2 * qblk - 8) : 0, n = 2 * qblk + 1 - kc_lo + 1;
    Stage S0 = Sn, S1;
    stage_store(S0, lds + L_KV + ((0 * 2 + half) * 2 + 0) * 8192, lds + L_KV + ((0 * 2 + half) * 2 + 1) * 8192, t256);
    if (n > 1) stage_load(S0, K, V, tokb + (long)(kc_lo + 1) * 64, hcol, t256);
    if (n > 2) stage_load(S1, K, V, tokb + (long)(kc_lo + 2) * 64, hcol, t256);
    __syncthreads();
    float mrun = -INFINITY, lrun = 0.f; f32x16 o[2]; o[0] = (f32x16){}; o[1] = (f32x16){};
    const f32x16 zero16 = {}; f32x16 bcv; { const float bc = tab[256];
#pragma unroll
        for (int r = 0; r < 16; ++r) bcv[r] = bc; }
    auto compute = [&](const int i, const int bufc) __attribute__((always_inline)) { const int kc = kc_lo + i;
        if (kc >= cq - 8 && kc <= cq) {
            const ALAS unsigned char* kbuf = lds + L_KV + ((bufc * 2 + half) * 2 + 0) * 8192; const ALAS unsigned char* vbuf = kbuf + 8192;
            f32x16 p0, p1;
            const int delta = cq - kc;
            if (delta >= 3) qk_tile(p0, p1, kbuf, qr, r32, hi, bcv);
            else { qk_tile(p0, p1, kbuf, qr, r32, hi, zero16);
                const int base = delta * 64 + iq0 + r32 + 128;
#pragma unroll
                for (int r = 0; r < 16; ++r) { const int i0 = base - crow(r, hi), i1 = i0 - 32; p0[r] += tab[i0 > 256 ? 256 : i0]; p1[r] += tab[i1 > 256 ? 256 : i1]; } }
            float mx = max3f(p0[0], p1[0], p0[1]);
#pragma unroll
            for (int r = 1; r < 15; ++r) mx = max3f(mx, p1[r], p0[r + 1]);
            mx = fmaxf(mx, p1[15]);
            mx = fmaxf(mx, __shfl_xor(mx, 32));
            const float mn = fmaxf(mrun, mx), f = __builtin_amdgcn_exp2f(mrun - mn); mrun = mn;
#pragma unroll
            for (int r = 0; r < 16; ++r) { p0[r] = __builtin_amdgcn_exp2f(p0[r] - mn); p1[r] = __builtin_amdgcn_exp2f(p1[r] - mn); }
            const f32x16 ps = p0 + p1;
            float rs = ((ps[0] + ps[1]) + (ps[2] + ps[3])) + ((ps[4] + ps[5]) + (ps[6] + ps[7])) + (((ps[8] + ps[9]) + (ps[10] + ps[11])) + ((ps[12] + ps[13]) + (ps[14] + ps[15])));
            rs += __shfl_xor(rs, 32);
            lrun = lrun * f + rs;
            if (__any(f != 1.0f)) { if (hi == 0) wsf[r32] = f; asm volatile("s_waitcnt lgkmcnt(0)" ::: "memory");
#pragma unroll
                for (int r = 0; r < 16; ++r) { const float ff = wsf[crow(r, hi)]; o[0][r] *= ff; o[1][r] *= ff; }
                asm volatile("s_waitcnt lgkmcnt(0)" ::: "memory"); }
            pv_tile(o, vbuf, p0, p1, lane, hi);
        }
    };
#define ATT_STEP(ii, bufc, SX) do { compute((ii), (bufc)); \
        if ((ii) + 1 < n) stage_store(SX, lds + L_KV + ((((bufc) ^ 1) * 2 + half) * 2 + 0) * 8192, lds + L_KV + ((((bufc) ^ 1) * 2 + half) * 2 + 1) * 8192, t256); \
        if ((ii) + 3 < n) stage_load(SX, K, V, tokb + (long)(kc_lo + (ii) + 3) * 64, hcol, t256); \
        __syncthreads(); } while (0)
    for (int i = 0; i < n; i += 2) { ATT_STEP(i, 0, S0); if (i + 1 < n) ATT_STEP(i + 1, 1, S1); }
#undef ATT_STEP
    if (qblk_next >= 0) chunk_prefetch(b, hp, qblk_next, Q, K, V, qn, Sn, tid);
    if (hi == 0) wsf[r32] = 1.0f / lrun;
    asm volatile("s_waitcnt lgkmcnt(0)" ::: "memory");
    store_o(o, lds, wid, lane, r32, hi, O + (size_t)(tokb + tq0) * DM + hcol, true);
}

__device__ __forceinline__ void stick_prefetch(int b, int hp, int qb, const bf16_t* Q, const bf16_t* K, const bf16_t* V, bf16x8 (&qn)[4], Stage& Sn, const int tid) {
    const int lane = tid & 63, r32 = lane & 31, hi = lane >> 5, wid = __builtin_amdgcn_readfirstlane(tid >> 6), half = wid >> 2, w4 = wid & 3, t256 = tid & 255;
    const int hcol = (2 * hp + half) * 64; const long tokb = (long)b * SEQ; const int tq = qb * 128 + w4 * 32 + r32, n = 2 * qb + 2;
#pragma unroll
    for (int d0 = 0; d0 < 4; ++d0) qn[d0] = *(const bf16x8*)(Q + (size_t)(tokb + tq) * DM + hcol + d0 * 16 + hi * 8);
    stage_load(Sn, K, V, tokb + (long)(n - 1) * 64, hcol, t256);
}
__device__ __forceinline__ void stick_attn_unit(int b, int hp, int qb, int qb_next, bf16x8 (&qn)[4], Stage& Sn, const bf16_t* Q, const bf16_t* K, const bf16_t* V, bf16_t* O, ALAS unsigned char* lds, const int tid) {
    const int lane = tid & 63, r32 = lane & 31, hi = lane >> 5, wid = __builtin_amdgcn_readfirstlane(tid >> 6), half = wid >> 2, w4 = wid & 3, t256 = tid & 255;
    const int h = 2 * hp + half, hcol = h * 64; const long tokb = (long)b * SEQ;
    const int tq0 = qb * 128 + w4 * 32, tq = tq0 + r32;
    ALAS unsigned* flg = (ALAS unsigned*)(lds + L_FLAG);
    bf16x8 qr[4];
#pragma unroll
    for (int d0 = 0; d0 < 4; ++d0) qr[d0] = qn[d0];
    const int n = 2 * qb + 2;
    Stage S0 = Sn, S1;
    stage_store(S0, lds + L_KV + ((0 * 2 + half) * 2 + 0) * 8192, lds + L_KV + ((0 * 2 + half) * 2 + 1) * 8192, t256);
    stage_load(S0, K, V, tokb + (long)(n - 2) * 64, hcol, t256);
    if (n > 2) stage_load(S1, K, V, tokb + (long)(n - 3) * 64, hcol, t256);
    __syncthreads();
    float carry = 0.f; f32x16 o[2]; o[0] = (f32x16){}; o[1] = (f32x16){};
    auto compute = [&](const int i, const int bufc) __attribute__((always_inline)) { const int kt = n - 1 - i, k0 = kt * 64;
        if (k0 < tq0 + 31) {
            const ALAS unsigned char* kbuf = lds + L_KV + ((bufc * 2 + half) * 2 + 0) * 8192; const ALAS unsigned char* vbuf = kbuf + 8192;
            f32x16 p0, p1; { const f32x16 zero16 = {}; qk_tile(p0, p1, kbuf, qr, r32, hi, zero16); }
            const bool needmask = (k0 + 63 >= tq0);
            f32x16 L0, L1;
#pragma unroll
            for (int r = 0; r < 16; ++r) {
                { const float zz = p0[r], e = __builtin_amdgcn_exp2f(-fabsf(zz)), lsp = __builtin_amdgcn_logf(1.0f + e); float lb = fminf(zz, 0.f) - lsp, l1 = lb - zz;
                  if (needmask && (k0 + crow(r, hi) >= tq)) { lb = -INFINITY; l1 = 0.f; } p0[r] = lb; L0[r] = l1; }
                { const float zz = p1[r], e = __builtin_amdgcn_exp2f(-fabsf(zz)), lsp = __builtin_amdgcn_logf(1.0f + e); float lb = fminf(zz, 0.f) - lsp, l1 = lb - zz;
                  if (needmask && (k0 + 32 + crow(r, hi) >= tq)) { lb = -INFINITY; l1 = 0.f; } p1[r] = lb; L1[r] = l1; }
            }
            float g0[4], g1[4], pg0[4], pg1[4];
#pragma unroll
            for (int g = 0; g < 4; ++g) { g0[g] = (L0[4 * g] + L0[4 * g + 1]) + (L0[4 * g + 2] + L0[4 * g + 3]); g1[g] = (L1[4 * g] + L1[4 * g + 1]) + (L1[4 * g + 2] + L1[4 * g + 3]); }
#pragma unroll
            for (int g = 0; g < 4; ++g) { pg0[g] = __shfl_xor(g0[g], 32); pg1[g] = __shfl_xor(g1[g], 32); }
            float suff = 0.f;
#pragma unroll
            for (int g = 3; g >= 0; --g) { const float e3 = carry + suff + (hi == 0 ? pg1[g] : 0.f), e2 = e3 + L1[4 * g + 3], e1 = e2 + L1[4 * g + 2], e0 = e1 + L1[4 * g + 1];
                p1[4 * g + 3] = __builtin_amdgcn_exp2f(p1[4 * g + 3] + e3); p1[4 * g + 2] = __builtin_amdgcn_exp2f(p1[4 * g + 2] + e2);
                p1[4 * g + 1] = __builtin_amdgcn_exp2f(p1[4 * g + 1] + e1); p1[4 * g + 0] = __builtin_amdgcn_exp2f(p1[4 * g + 0] + e0);
                suff += g1[g] + pg1[g]; }
            carry += suff; suff = 0.f;
#pragma unroll
            for (int g = 3; g >= 0; --g) { const float e3 = carry + suff + (hi == 0 ? pg0[g] : 0.f), e2 = e3 + L0[4 * g + 3], e1 = e2 + L0[4 * g + 2], e0 = e1 + L0[4 * g + 1];
                p0[4 * g + 3] = __builtin_amdgcn_exp2f(p0[4 * g + 3] + e3); p0[4 * g + 2] = __builtin_amdgcn_exp2f(p0[4 * g + 2] + e2);
                p0[4 * g + 1] = __builtin_amdgcn_exp2f(p0[4 * g + 1] + e1); p0[4 * g + 0] = __builtin_amdgcn_exp2f(p0[4 * g + 0] + e0);
                suff += g0[g] + pg0[g]; }
            carry += suff;
            pv_tile(o, vbuf, p0, p1, lane, hi);
        }
    };
    bool stop = false;
#define ATT_STEP(ii, bufc, SX) do { compute((ii), (bufc)); \
        { const int alld = __all(carry < -150.0f); if (lane == 0) flg[(bufc) * 8 + wid] = (unsigned)alld; } \
        if ((ii) + 1 < n) stage_store(SX, lds + L_KV + ((((bufc) ^ 1) * 2 + half) * 2 + 0) * 8192, lds + L_KV + ((((bufc) ^ 1) * 2 + half) * 2 + 1) * 8192, t256); \
        if ((ii) + 3 < n) stage_load(SX, K, V, tokb + (long)(n - 1 - ((ii) + 3)) * 64, hcol, t256); \
        __syncthreads(); \
        { const ALAS u32x4* fp = (const ALAS u32x4*)(flg + (bufc) * 8); const u32x4 f0 = fp[0], f1 = fp[1]; \
          stop = (f0[0] & f0[1] & f0[2] & f0[3] & f1[0] & f1[1] & f1[2] & f1[3]) != 0u; } } while (0)
    for (int i = 0; i < n; i += 2) { ATT_STEP(i, 0, S0); if (stop) break; if (i + 1 < n) { ATT_STEP(i + 1, 1, S1); if (stop) break; } }
#undef ATT_STEP
    if (qb_next >= 0) stick_prefetch(b, hp, qb_next, Q, K, V, qn, Sn, tid);
    store_o(o, lds, wid, lane, r32, hi, O + (size_t)(tokb + tq0) * DM + hcol, false);
}
#undef ALAS
}

#define GAS __attribute__((address_space(1)))
#define LAS __attribute__((address_space(3)))
typedef unsigned short bf16;
typedef unsigned v4u __attribute__((ext_vector_type(4)));
typedef float f32x4 __attribute__((ext_vector_type(4)));
typedef short bf16x8 __attribute__((ext_vector_type(8)));
typedef GAS unsigned gu32;
typedef GAS unsigned long long gu64;
#define RLX_AGENT __ATOMIC_RELAXED, __HIP_MEMORY_SCOPE_AGENT
#define LDS_WAIT() asm volatile("s_waitcnt lgkmcnt(0)" ::: "memory")
#define VM_WAIT() asm volatile("s_waitcnt vmcnt(0)" ::: "memory")
__device__ __forceinline__ unsigned long long rt() { return __builtin_amdgcn_s_memrealtime(); }
__device__ __forceinline__ unsigned f2bf(float f) { unsigned u = __builtin_bit_cast(unsigned, f); return (u + 0x7fffu + ((u >> 16) & 1u)) >> 16; }
__device__ __forceinline__ unsigned pk2(float lo, float hi) { return f2bf(lo) | (f2bf(hi) << 16); }

#define XB_TMO      128
#define XB_XCNT(j)  (256  + 64 * (j))
#define XB_XSUB(j)  (1280 + 64 * (j))
#define XB_XGEN(j)  (2304 + 64 * (j))
#define XB_TOP      3328
#define XB_TOPGEN   3392
#define XCD_BAR_WORDS 3456
#define XB_SPIN_CAP (1u << 18)

__device__ __forceinline__ unsigned xb_ld(unsigned* p)              { return __hip_atomic_load(p, __ATOMIC_RELAXED, __HIP_MEMORY_SCOPE_AGENT); }
__device__ __forceinline__ unsigned xb_add(unsigned* p, unsigned v) { return __hip_atomic_fetch_add(p, v, __ATOMIC_RELAXED, __HIP_MEMORY_SCOPE_AGENT); }
__device__ __forceinline__ unsigned xb_xcc_id() { return (unsigned)__builtin_amdgcn_s_getreg((3 << 11) | 20) & 0xFu; }
#define XB_SPIN(cond, bar) do { unsigned _sp = 0; while (cond) { __builtin_amdgcn_s_sleep(1); \
    if ((++_sp & 255u) == 0u) { if (xb_ld(&(bar)[XB_TMO])) break; if (_sp > XB_SPIN_CAP) { atomicAdd(&(bar)[XB_TMO], 1u); break; } } } } while (0)

struct XcdBarrier {
    unsigned* bar; unsigned x;
    volatile LAS unsigned* st;
};

__device__ __forceinline__ XcdBarrier xcd_barrier_post(unsigned* bar, volatile LAS unsigned* st) {
    XcdBarrier b; b.bar = bar; b.x = xb_xcc_id(); b.st = st;
    if (threadIdx.x == 0) (void)xb_add(&bar[XB_XCNT(b.x)], 1u);
    return b;
}
__device__ __forceinline__ void xcd_barrier_complete(unsigned* bar, unsigned x, unsigned& nloc, unsigned& nx) {
    const unsigned G = gridDim.x * gridDim.y * gridDim.z;
    unsigned sum, cnt, mine, sp = 0u;
    for (;;) {
        sum = 0u; cnt = 0u; mine = 0u;
#pragma unroll
        for (unsigned j = 0; j < 16; ++j) { const unsigned c = xb_ld(&bar[XB_XCNT(j)]); sum += c; cnt += (c > 0u) ? 1u : 0u; mine = (j == x) ? c : mine; }
        if (sum == G) break;
        __builtin_amdgcn_s_sleep(1);
        if ((++sp & 255u) == 0u) { if (xb_ld(&bar[XB_TMO])) break; if (sp > XB_SPIN_CAP) { atomicAdd(&bar[XB_TMO], 1u); break; } }
    }
    nloc = mine > 0u ? mine : 1u; nx = cnt > 0u ? cnt : 1u;
}

__device__ __forceinline__ void xcd_barrier(const XcdBarrier& b) {
    asm volatile("s_waitcnt vmcnt(0)" ::: "memory");
    __syncthreads();
    if (threadIdx.x == 0) {
        unsigned* bar = b.bar;
        __builtin_amdgcn_s_waitcnt(0);
        unsigned nloc = b.st[0], nx = b.st[1];
        if (nloc == 0u) { xcd_barrier_complete(bar, b.x, nloc, nx); b.st[0] = nloc; b.st[1] = nx; }
        const unsigned old = xb_add(&bar[XB_XSUB(b.x)], 1u);
        const unsigned gen = old / nloc;
        if (old + 1u == (gen + 1u) * nloc) {
            __builtin_amdgcn_fence(__ATOMIC_RELEASE, "agent");
            asm volatile("s_waitcnt vmcnt(0)" ::: "memory");
            const unsigned og = xb_add(&bar[XB_TOP], 1u);
            const unsigned tg = og / nx;
            if (og + 1u == (tg + 1u) * nx) xb_add(&bar[XB_TOPGEN], 1u);
            else XB_SPIN(xb_ld(&bar[XB_TOPGEN]) == tg, bar);
            __builtin_amdgcn_fence(__ATOMIC_ACQUIRE, "agent");
            xb_add(&bar[XB_XGEN(b.x)], 1u);
            asm volatile("s_waitcnt vmcnt(0)" ::: "memory");
        } else {
            XB_SPIN(xb_ld(&bar[XB_XGEN(b.x)]) == gen, bar);
            __builtin_amdgcn_fence(__ATOMIC_ACQUIRE, "agent");
            asm volatile("s_waitcnt vmcnt(0)" ::: "memory");
        }
    }
    __syncthreads();
}
constexpr int NWAVES = 8;
constexpr int BATCH = 16, SEQ = 2048, D = 1024, FF = 2816, DEPTH = 4, M = BATCH * SEQ;
constexpr size_t MiB = 1u << 20;
constexpr size_t WS_CTL = 0, CTL_ZERO_BYTES = 4 * MiB;
constexpr int CW_BAR = 1024;
constexpr size_t WS_CS = 64 * 1024, WS_BW = 320 * 1024;
constexpr int CSV_QKV = 8 * 2 * FF;
constexpr size_t WS_IDSTAT = 640 * 1024;
constexpr size_t WS_STAT = 1 * MiB;
constexpr size_t WS_W1 = 4 * MiB;
constexpr size_t WS_W2 = WS_W1 + 88 * MiB;
constexpr size_t WS_WQKV = WS_W2 + 44 * MiB;
constexpr size_t WS_WO = WS_WQKV + 24 * MiB;
constexpr size_t WS_ZB = WS_WO + 8 * MiB;
constexpr size_t WS_QKV = WS_ZB + 64 * MiB;
constexpr size_t WS_Z16 = WS_QKV + 192 * MiB;
constexpr size_t WS_END = WS_Z16 + 64 * MiB;
constexpr int LDS_STAGE = 131072, GB_OFF = LDS_STAGE, MISC_OFF = GB_OFF + 8192, STASH_OFF = MISC_OFF + 512, ULIST_OFF = STASH_OFF + 4096, LDS_BYTES = ULIST_OFF + 1024;


typedef _Float16 h2_t __attribute__((ext_vector_type(2)));
__device__ __forceinline__ unsigned pk2h(float lo, float hi) { const h2_t h = (h2_t){(_Float16)lo, (_Float16)hi}; return __builtin_bit_cast(unsigned, h); }
__device__ __forceinline__ void transpose_item(const float* W, int N, bf16* WT, int Kt, int k0, int n0, int dst_row0, const float* gvec, const float* bvec, float* cs, float* bw, LAS float* scr, int lane, const bool f16out) {
    float csp[4] = {0.f, 0.f, 0.f, 0.f}, bwp[4] = {0.f, 0.f, 0.f, 0.f};
    const int c4 = lane & 7, kq = lane >> 3;
    f32x4 wv[8]; float gk[8], bk[8];
#pragma unroll
    for (int i = 0; i < 8; ++i) wv[i] = *(const f32x4*)(W + (size_t)(k0 + 8 * i + kq) * N + n0 + 4 * c4);
    if (gvec) {
#pragma unroll
        for (int i = 0; i < 8; ++i) { gk[i] = gvec[k0 + 8 * i + kq]; bk[i] = bvec[k0 + 8 * i + kq]; }
    } else {
#pragma unroll
        for (int i = 0; i < 8; ++i) { gk[i] = 1.0f; bk[i] = 0.0f; }
    }
#pragma unroll
    for (int i = 0; i < 8; ++i) { const int kk = 8 * i + kq;
#pragma unroll
        for (int j = 0; j < 4; ++j) { const float wsc = wv[i][j] * gk[i]; scr[kk * 33 + 4 * c4 + j] = wsc; csp[j] += f16out ? (float)(_Float16)wsc : __builtin_bit_cast(float, f2bf(wsc) << 16); bwp[j] += bk[i] * wv[i][j]; } }
    if (cs) {
#pragma unroll
        for (int j = 0; j < 4; ++j) { csp[j] += __shfl_xor(csp[j], 8); csp[j] += __shfl_xor(csp[j], 16); csp[j] += __shfl_xor(csp[j], 32); bwp[j] += __shfl_xor(bwp[j], 8); bwp[j] += __shfl_xor(bwp[j], 16); bwp[j] += __shfl_xor(bwp[j], 32); }
        if (lane < 8) {
#pragma unroll
            for (int j = 0; j < 4; ++j) { unsafeAtomicAdd(cs + dst_row0 + 4 * c4 + j, csp[j]); unsafeAtomicAdd(bw + dst_row0 + 4 * c4 + j, bwp[j]); } } }
    LDS_WAIT(); asm volatile("" ::: "memory");
    const int c = lane & 7;
#pragma unroll
    for (int j = 0; j < 4; ++j) { const int n = (lane >> 3) + 8 * j; const LAS float* s = scr + (8 * c) * 33 + n;
        v4u o; if (f16out) { o.x = pk2h(s[0 * 33], s[1 * 33]); o.y = pk2h(s[2 * 33], s[3 * 33]); o.z = pk2h(s[4 * 33], s[5 * 33]); o.w = pk2h(s[6 * 33], s[7 * 33]); }
        else { o.x = pk2(s[0 * 33], s[1 * 33]); o.y = pk2(s[2 * 33], s[3 * 33]); o.z = pk2(s[4 * 33], s[5 * 33]); o.w = pk2(s[6 * 33], s[7 * 33]); }
        *(v4u*)(WT + (size_t)(dst_row0 + n) * Kt + k0 + 8 * c) = o; }
    LDS_WAIT(); asm volatile("" ::: "memory");
}
__device__ __forceinline__ float wave_sum(float v) {
#pragma unroll
    for (int o = 1; o < 64; o <<= 1) v += __shfl_xor(v, o);
    return v;
}

#ifndef PROBE_GROUP
#define PROBE_GROUP 0
#endif
#define PROBE_T0(grp) unsigned long long pt0_ = 0; if (PROBE_GROUP == (grp)) pt0_ = __builtin_amdgcn_s_memrealtime();
#define PROBE_T1(grp) if (PROBE_GROUP == (grp)) { const unsigned long long pt1_ = __builtin_amdgcn_s_memrealtime(); while (__builtin_amdgcn_s_memrealtime() - pt1_ < pt1_ - pt0_) __builtin_amdgcn_s_sleep(8); }
#ifndef GEMM_F16
#define GEMM_F16 true
#endif
struct Args { const float* in[11]; float* out; unsigned char* ws; };

__global__ void __launch_bounds__(NWAVES * 64, 2) fwd_megakernel(Args args) {
    extern __shared__ __attribute__((aligned(16))) unsigned char lds_raw[];
    LAS unsigned char* lds = (LAS unsigned char*)lds_raw;
    volatile LAS unsigned* MISC = (volatile LAS unsigned*)(lds + MISC_OFF);
    const int wave = __builtin_amdgcn_readfirstlane(threadIdx.x >> 6);
    const int G = gridDim.x, bx = blockIdx.x;
    unsigned char* ws = args.ws;
    unsigned* ctl = (unsigned*)(ws + WS_CTL);
    const float* x_in = args.in[0]; const float* rel = args.in[3]; const float* ln_g = args.in[9]; const float* ln_b = args.in[10];
    float* zout = args.out;
    float* IDSTAT = (float*)(ws + WS_IDSTAT);
    float* CS = (float*)(ws + WS_CS); float* BW = (float*)(ws + WS_BW); float* STAT = (float*)(ws + WS_STAT);
    bf16* W1T = (bf16*)(ws + WS_W1); bf16* W2T = (bf16*)(ws + WS_W2); bf16* WQKVT = (bf16*)(ws + WS_WQKV); bf16* WOT = (bf16*)(ws + WS_WO);
    _Float16* Z16 = GEMM_F16 ? (_Float16*)(ws + WS_ZB) : (_Float16*)(ws + WS_Z16);
    bf16* ZB = (bf16*)(ws + WS_ZB); bf16* QB = (bf16*)(ws + WS_QKV); bf16* KB = QB + (size_t)M * D; bf16* VB = KB + (size_t)M * D; bf16* HB = QB;
    for (int u = threadIdx.x; u < (STASH_OFF - MISC_OFF) / 4; u += NWAVES * 64) ((LAS unsigned*)(lds + MISC_OFF))[u] = 0u;
    __syncthreads();
    XcdBarrier bar = xcd_barrier_post(ctl + CW_BAR, MISC + 8);

    {
        PROBE_T0(3)
        const int tid = threadIdx.x, lane = tid & 63;
        LAS float* scr = (LAS float*)(lds + wave * 16384);
        const int gw = bx * NWAVES + wave, NGW = G * NWAVES;
        constexpr int I_F = 16 * 88, N_FFN = 8 * 3 * I_F, I_QKV = 16 * 96, I_O = 16 * 32, N_MIX = 4 * (I_QKV + I_O);
        for (int it = gw; it < N_FFN + N_MIX; it += NGW) {
            if (it < N_FFN) { const int mi = it / I_F, r = it % I_F, f = mi / 3, which = mi % 3;
                if (which < 2) { const int kb = r / 88, nb = r % 88, n0 = 32 * nb, s = 3 * (f >> 1) + 2 * (f & 1);
                    const float* W = args.in[6 + which] + (size_t)f * D * FF;
                    const int dst = (n0 >> 7) * 256 + (n0 & 127) + which * 128;
                    transpose_item(W, FF, W1T + (size_t)f * 2 * FF * D, D, 64 * kb, n0, dst, s > 0 ? ln_g + (s - 1) * D : nullptr, s > 0 ? ln_b + (s - 1) * D : nullptr, CS + f * 2 * FF, BW + f * 2 * FF, scr, lane, GEMM_F16);
                } else { const int kb = r / 32, nb = r % 32;
                    transpose_item(args.in[8] + (size_t)f * FF * D, D, W2T + (size_t)f * D * FF, FF, 64 * kb, 32 * nb, 32 * nb, nullptr, nullptr, nullptr, nullptr, scr, lane, false); }
            } else { const int it2 = it - N_FFN, li = it2 / (I_QKV + I_O), r = it2 % (I_QKV + I_O), j = li >> 1, s = 3 * li + 1;
                if (r < I_QKV) { const int kb = r / 96, nb = r % 96;
                    const float* W = args.in[(li & 1) ? 4 : 1] + (size_t)j * D * 3 * D;
                    transpose_item(W, 3 * D, WQKVT + (size_t)li * 3 * D * D, D, 64 * kb, 32 * nb, 32 * nb, ln_g + (s - 1) * D, ln_b + (s - 1) * D, CS + CSV_QKV + li * 3 * D, BW + CSV_QKV + li * 3 * D, scr, lane, GEMM_F16);
                } else { const int r2 = r - I_QKV, kb = r2 / 32, nb = r2 % 32;
                    const float* W = args.in[(li & 1) ? 5 : 2] + (size_t)j * D * D;
                    transpose_item(W, D, WOT + (size_t)li * D * D, D, 64 * kb, 32 * nb, 32 * nb, nullptr, nullptr, nullptr, nullptr, scr, lane, false); }
            }
        }
        for (int r = bx * (NWAVES * 64) + tid; r < M; r += G * NWAVES * 64) { IDSTAT[2 * r] = 0.0f; IDSTAT[2 * r + 1] = 1024.0f * (1.0f - 1e-5f); }
        const size_t nch = (size_t)M * D / 8, nthr = (size_t)G * NWAVES * 64;
        size_t c = (size_t)bx * (NWAVES * 64) + tid;
        for (; c + 3 * nthr < nch; c += 4 * nthr) {
            f32x4 a[4], b[4];
#pragma unroll
            for (int j = 0; j < 4; ++j) { a[j] = *(const f32x4*)(x_in + (c + j * nthr) * 8); b[j] = *(const f32x4*)(x_in + (c + j * nthr) * 8 + 4); }
#pragma unroll
            for (int j = 0; j < 4; ++j) { v4u o; o.x = pk2h(a[j][0], a[j][1]); o.y = pk2h(a[j][2], a[j][3]); o.z = pk2h(b[j][0], b[j][1]); o.w = pk2h(b[j][2], b[j][3]); *(v4u*)(ZB + (c + j * nthr) * 8) = o; } }
        for (; c < nch; c += nthr) { const f32x4 a = *(const f32x4*)(x_in + c * 8), b = *(const f32x4*)(x_in + c * 8 + 4);
            v4u o; o.x = pk2h(a[0], a[1]); o.y = pk2h(a[2], a[3]); o.z = pk2h(b[0], b[1]); o.w = pk2h(b[2], b[3]); *(v4u*)(ZB + c * 8) = o; }
        PROBE_T1(3)
    }
    __syncthreads();
    cg::this_grid().sync();

#define GRID_BAR() do { PROBE_T0(4) xcd_barrier(bar); PROBE_T1(4) } while (0)
#define GRID_BAR_C(cls) do { PROBE_T0(cls) xcd_barrier(bar); PROBE_T1(cls) } while (0)
#pragma unroll 1
    for (int li_ = 0; li_ < DEPTH; ++li_) {
#pragma unroll 1
        for (int sub_ = 0; sub_ < 3; ++sub_) {
            int li = li_, sub = sub_; asm volatile("" : "+s"(li), "+s"(sub)); unsigned zv_; asm volatile("v_mov_b32 %0, 0" : "=v"(zv_)); int tidv = wave * 64 + (int)__builtin_amdgcn_mbcnt_hi(~0u, __builtin_amdgcn_mbcnt_lo(~0u, zv_)); asm volatile("" : "+v"(tidv));
            const int s = 3 * li + sub;
            const float* stat_in = s > 0 ? STAT + (size_t)(s - 1) * M * 2 : IDSTAT;
            float* stat_out = STAT + (size_t)s * M * 2;
            const float* gin = ln_g + (s > 0 ? s - 1 : 0) * D; const float* bin = ln_b + (s > 0 ? s - 1 : 0) * D;
            { LAS float* gbw = (LAS float*)(lds + GB_OFF); for (int c = tidv; c < D; c += NWAVES * 64) { gbw[c] = s > 0 ? gin[c] : 1.0f; gbw[D + c] = s > 0 ? bin[c] : 0.0f; } }
            __syncthreads();
            if (sub != 1) {
                const int f = 2 * li + (sub >> 1);
                { PROBE_T0(1) pg8::Gemm g{ZB, W1T + (size_t)f * 2 * FF * D, M, 2 * FF, D}; pg8::StaticOrder S; S.init(M, 2 * FF, G, bx);
                  pg8::EpiSwiglu E{HB, stat_in, CS + f * 2 * FF, BW + f * 2 * FF, (LAS float*)(lds + STASH_OFF)};
                  asm volatile("" : "+v"(tidv)); { const pg8::ListOrder LO = pg8::make_list(S, (LAS int*)(lds + ULIST_OFF), tidv); pg8::gemm_phase<pg8::EpiSwiglu, pg8::ListOrder, true, true, GEMM_F16>(lds, tidv, g, LO, E); } PROBE_T1(1) }
                GRID_BAR_C(11);
                { PROBE_T0(1) pg8::Gemm g{HB, W2T + (size_t)f * D * FF, M, D, FF}; pg8::StaticOrder S; S.init(M, D, G, bx, 1);
                  pg8::EpiResid E{Z16, stat_in, (const LAS float*)(lds + GB_OFF), stat_out, 0.5f};
                  asm volatile("" : "+v"(tidv)); { const pg8::ListOrder LO = pg8::make_list(S, (LAS int*)(lds + ULIST_OFF), tidv); pg8::gemm_phase<pg8::EpiResid, pg8::ListOrder, true, true>(lds, tidv, g, LO, E); } PROBE_T1(1) }
                GRID_BAR_C(12);
            } else {
                { PROBE_T0(1) pg8::Gemm g{ZB, WQKVT + (size_t)li * 3 * D * D, M, 3 * D, D}; pg8::StaticOrder S; S.init(M, 3 * D, G, bx);
                  pg8::EpiQKV E{QB, (size_t)M * D, stat_in, CS + CSV_QKV + li * 3 * D, BW + CSV_QKV + li * 3 * D, 0.125f * 1.4426950408889634f, (LAS float*)(lds + STASH_OFF)};
                  asm volatile("" : "+v"(tidv)); { const pg8::ListOrder LO = pg8::make_list(S, (LAS int*)(lds + ULIST_OFF), tidv); pg8::gemm_phase<pg8::EpiQKV, pg8::ListOrder, true, true, GEMM_F16>(lds, tidv, g, LO, E); } PROBE_T1(1) }
                GRID_BAR_C(13);
                asm volatile("" : "+v"(tidv));
                { PROBE_T0(2)
                for (int vb = bx; vb < 256; vb += G) { const int grp = vb >> 1, e = vb & 1, b = grp >> 3, hp = grp & 7;
                    att::bf16x8 qn[4]; att::Stage Sn;
                    if ((li & 1) == 0) { att::chunk_prefetch(b, hp, e ^ 1, QB, KB, VB, qn, Sn, tidv);
                        for (int i = 0; i < 8; ++i) { asm volatile("" : "+v"(tidv)); att::chunk_attn_unit(b, hp, i == 0 ? (e ^ 1) : 2 * i + e, i < 7 ? 2 * (i + 1) + e : -1, qn, Sn, QB, KB, VB, QB, rel, lds, tidv); } }
                    else { att::stick_prefetch(b, hp, e, QB, KB, VB, qn, Sn, tidv);
                        for (int i = 0; i < 8; ++i) { const int k = 2 * (i >> 1) + e, qb = (i & 1) ? 15 - k : k, i1 = i + 1, k1 = 2 * (i1 >> 1) + e, qb1 = i1 < 8 ? ((i1 & 1) ? 15 - k1 : k1) : -1;
                            asm volatile("" : "+v"(tidv)); att::stick_attn_unit(b, hp, qb, qb1, qn, Sn, QB, KB, VB, QB, lds, tidv); } } }
                PROBE_T1(2) }
                GRID_BAR_C(14);
                { PROBE_T0(1) pg8::Gemm g{QB, WOT + (size_t)li * D * D, M, D, D}; pg8::StaticOrder S; S.init(M, D, G, bx);
                  pg8::EpiResid E{Z16, stat_in, (const LAS float*)(lds + GB_OFF), stat_out, 1.0f};
                  asm volatile("" : "+v"(tidv)); { const pg8::ListOrder LO = pg8::make_list(S, (LAS int*)(lds + ULIST_OFF), tidv); pg8::gemm_phase<pg8::EpiResid, pg8::ListOrder, true, true>(lds, tidv, g, LO, E); } PROBE_T1(1) }
                GRID_BAR_C(15);
            }
        }
    }
    {
        PROBE_T0(5)
        unsigned zv2_; asm volatile("v_mov_b32 %0, 0" : "=v"(zv2_)); const int lane = (int)__builtin_amdgcn_mbcnt_hi(~0u, __builtin_amdgcn_mbcnt_lo(~0u, zv2_));
        const int gw = bx * NWAVES + wave, NGW = G * NWAVES; const float* gl = ln_g + 11 * D; const float* bl = ln_b + 11 * D;
        f32x4 ggv[4], bbv[4];
#pragma unroll
        for (int j = 0; j < 4; ++j) { const int c4 = 2 * lane + (j & 1) + 128 * (j >> 1); ggv[j] = *((const f32x4*)gl + c4); bbv[j] = *((const f32x4*)bl + c4); }
        auto ln_rows = [&](const int m0, const int nr) __attribute__((always_inline)) {
            pg8::f16x8 h[2][2];
#pragma unroll
            for (int r = 0; r < 2; ++r) if (r < nr) { const pg8::f16x8* zr16 = (const pg8::f16x8*)(Z16 + (size_t)(m0 + r * NGW) * D) + lane;
                h[r][0] = zr16[0]; h[r][1] = zr16[64]; }
#pragma unroll
            for (int r = 0; r < 2; ++r) if (r < nr) { const int m = m0 + r * NGW; f32x4 v[4]; float s = 0.f;
#pragma unroll
                for (int jj = 0; jj < 2; ++jj) { v[2 * jj] = (f32x4){(float)h[r][jj][0], (float)h[r][jj][1], (float)h[r][jj][2], (float)h[r][jj][3]}; v[2 * jj + 1] = (f32x4){(float)h[r][jj][4], (float)h[r][jj][5], (float)h[r][jj][6], (float)h[r][jj][7]}; }
#pragma unroll
                for (int j = 0; j < 4; ++j) s += (v[j][0] + v[j][1]) + (v[j][2] + v[j][3]);
                const float mean = wave_sum(s) * (1.f / D); float s2 = 0.f;
#pragma unroll
                for (int j = 0; j < 4; ++j) { v[j] = v[j] - mean; s2 += (v[j][0] * v[j][0] + v[j][1] * v[j][1]) + (v[j][2] * v[j][2] + v[j][3] * v[j][3]); }
                const float rstd = 1.f / sqrtf(wave_sum(s2) * (1.f / D) + 1e-5f);
#pragma unroll
                for (int j = 0; j < 4; ++j) { const int c4 = 2 * lane + (j & 1) + 128 * (j >> 1);
                    *((f32x4*)(zout + (size_t)m * D) + c4) = v[j] * rstd * ggv[j] + bbv[j]; } }
        };
        int m = gw;
        for (; m + NGW < M; m += 2 * NGW) ln_rows(m, 2);
        if (m < M) ln_rows(m, 1);
        PROBE_T1(5)
    }
}

extern "C" void kernel_launch(void* const* d_in, const int* in_sizes, int n_in, void* d_out, int out_size, void* d_ws, size_t ws_size, hipStream_t stream) {
    static int grid = 0;
    if (grid == 0) {
        if (n_in != 11 || ws_size < WS_END) { fprintf(stderr, "kernel_launch: unexpected inputs (n_in %d, ws %zu)\n", n_in, ws_size); grid = -1; return; }
        int dev = 0, cus = 0, per_cu = 0;
        (void)hipGetDevice(&dev); (void)hipDeviceGetAttribute(&cus, hipDeviceAttributeMultiprocessorCount, dev);
        (void)hipFuncSetAttribute((const void*)fwd_megakernel, hipFuncAttributeMaxDynamicSharedMemorySize, LDS_BYTES);
        if (hipOccupancyMaxActiveBlocksPerMultiprocessor(&per_cu, (const void*)fwd_megakernel, NWAVES * 64, LDS_BYTES) != hipSuccess || per_cu < 1) { fprintf(stderr, "kernel_launch: occupancy query says %d\n", per_cu); per_cu = 1; }
        (void)hipGetLastError();
        grid = cus;
        if (grid > 256) grid = 256;
    }
    if (grid < 0) return;
    (void)hipMemsetAsync((char*)d_ws + WS_CTL, 0, CTL_ZERO_BYTES, stream);
    Args a{};
    for (int i = 0; i < 11; ++i) a.in[i] = (const float*)d_in[i];
    a.out = (float*)d_out; a.ws = (unsigned char*)d_ws;
    void* kargs[] = {&a};
    hipError_t e = hipLaunchCooperativeKernel((const void*)fwd_megakernel, dim3(grid), dim3(NWAVES * 64), kargs, LDS_BYTES, stream);
    if (e != hipSuccess) fprintf(stderr, "cooperative launch failed: %s (grid %d)\n", hipGetErrorString(e), grid);
}
```

```cpp
#include <hip/hip_runtime.h>
#include <hip/hip_cooperative_groups.h>
#include <cstdio>
#include <cstdint>
namespace cg = cooperative_groups;
namespace pg8 {
#define PG8_LAS __attribute__((address_space(3)))
typedef unsigned short bf16_t;
typedef short bf16x8 __attribute__((ext_vector_type(8)));
typedef float f32x4 __attribute__((ext_vector_type(4)));
typedef unsigned u32x4 __attribute__((ext_vector_type(4)));
constexpr int BM = 256, BK = 64, HALF = 128, HTB = HALF * BK * 2  , STAGE_BYTES = 8 * HTB, NXCD = 8, WGM = 8;

__host__ __device__ __forceinline__ int lds_byte(int r, int c) { const int st = (r >> 4) * 2 + (c >> 5), rr = r & 15, cc = c & 31, ob = rr * 64 + cc * 2; return st * 1024 + (ob ^ (((ob >> 9) & 1) << 5)); }
__host__ __device__ __forceinline__ void stage_rc(int b, int& R, int& C) { const int st = b / 1024, sb = b % 1024, swz = sb ^ (((sb >> 9) & 1) << 5); R = (st >> 1) * 16 + swz / 64; C = (st & 1) * 32 + (swz % 64) / 2; }
__host__ __device__ __forceinline__ int perm32(int rho) { const int n = rho >> 4, i = rho & 15; return 8 * (i >> 2) + 4 * n + (i & 3); }

struct Unit { int pm, pn; };
struct Gemm { const bf16_t* A; const bf16_t* Bt; int M, N, K; };

struct StaticOrder {
    int nM, nN, nwg, G, c, rev;
    __host__ __device__ void init(int M, int N, int G_, int c_, int rev_ = 0) { nM = M / BM; nN = N / BM; nwg = nM * nN; G = G_; c = c_; rev = (rev_ && nwg % G_ == 0) ? nwg / G_ : 0; }
    __host__ __device__ bool next(int i, Unit& u) const {
        const long L = (long)(rev ? rev - 1 - i : i) * G + c; if (L >= nwg || L < 0) return false;
        int wgid = (int)L; { const int q = nwg / NXCD, r = nwg % NXCD, xcd = wgid % NXCD, off = wgid / NXCD; wgid = (xcd < r ? xcd * (q + 1) : r * (q + 1) + (xcd - r) * q) + off; }
        const int nig = WGM * nN, gid = wgid / nig, fm = gid * WGM, gsz = (nM - fm) < WGM ? (nM - fm) : WGM;
        u.pm = fm + ((wgid % nig) % gsz); u.pn = (wgid % nig) / gsz; return true;
    }
    __device__ __forceinline__ void a_ready(const Unit&) const {}
    __device__ __forceinline__ void done(const Unit&) const {}
};

struct ListOrder {
    const PG8_LAS int* list; int count;
    __device__ __forceinline__ bool next(int i, Unit& u) const { if (i >= count) return false; u.pm = __builtin_amdgcn_readfirstlane(list[2 * i]); u.pn = __builtin_amdgcn_readfirstlane(list[2 * i + 1]); return true; }
    __device__ __forceinline__ void a_ready(const Unit&) const {}
    __device__ __forceinline__ void done(const Unit&) const {}
};
__device__ __forceinline__ ListOrder make_list(const StaticOrder& S, PG8_LAS int* lst, int tid) {
    int cnt = 0; if (S.c < S.nwg) cnt = (S.nwg - S.c + S.G - 1) / S.G; if (cnt > 128) cnt = 128;
    if (tid < cnt) { Unit u; u.pm = 0; u.pn = 0; (void)S.next(tid, u); lst[2 * tid] = u.pm; lst[2 * tid + 1] = u.pn; }
    __syncthreads();
    ListOrder L; L.list = lst; L.count = cnt; return L;
}

__device__ __forceinline__ unsigned cvt_pk_bf16(float lo, float hi) { unsigned r; asm volatile("v_cvt_pk_bf16_f32 %0, %1, %2" : "=v"(r) : "v"(lo), "v"(hi)); return r; }
typedef float f32x2 __attribute__((ext_vector_type(2)));
typedef _Float16 f16x8 __attribute__((ext_vector_type(8)));
template <bool F16> __device__ __forceinline__ f32x4 mma16(bf16x8 a, bf16x8 b, f32x4 c) {
    if constexpr (F16) return __builtin_amdgcn_mfma_f32_16x16x32_f16(__builtin_bit_cast(f16x8, a), __builtin_bit_cast(f16x8, b), c, 0, 0, 0);
    else return __builtin_amdgcn_mfma_f32_16x16x32_bf16(a, b, c, 0, 0, 0);
}
__device__ __forceinline__ float ld_agent_f32(const float* p) { return __hip_atomic_load(p, __ATOMIC_RELAXED, __HIP_MEMORY_SCOPE_AGENT); }
typedef unsigned u32x2 __attribute__((ext_vector_type(2)));
__device__ __forceinline__ void row_stats8(const float* st, int row0, float (&mu)[2][4], float (&rs)[2][4]) {
#pragma unroll
    for (int ai = 0; ai < 2; ++ai)
#pragma unroll
        for (int m = 0; m < 4; ++m) { if (st) { const int row = row0 + ai * HALF + m * 16; const f32x2 sq = *(const f32x2*)(st + 2 * row);
            const float mm = sq[0] * (1.0f / 1024.0f), var = fmaxf(sq[1] * (1.0f / 1024.0f) - mm * mm, 0.f); mu[ai][m] = mm; rs[ai][m] = __builtin_amdgcn_rsqf(var + 1e-5f); } else { mu[ai][m] = 0.f; rs[ai][m] = 1.f; } }
}
__device__ __forceinline__ void stash_unit(const Unit& u, int wid, int lane, const float* cs, const float* bw, const float* stat, PG8_LAS float* st) {
    const float* src = (wid < 4 ? cs : bw) + u.pn * BM + (wid & 3) * 64 + lane;
    __builtin_amdgcn_global_load_lds((const unsigned*)src, (PG8_LAS unsigned*)(st + wid * 64), 4, 0, 0);
    __builtin_amdgcn_global_load_lds((const unsigned*)(stat + 2 * (size_t)(u.pm * BM) + wid * 64 + lane), (PG8_LAS unsigned*)(st + 512 + wid * 64), 4, 0, 0);
}
__device__ __forceinline__ void row_stats8_lds(const PG8_LAS float* st, int rl0, float (&mu)[2][4], float (&rs)[2][4]) {
#pragma unroll
    for (int ai = 0; ai < 2; ++ai)
#pragma unroll
        for (int m = 0; m < 4; ++m) { const f32x2 sq = *(const PG8_LAS f32x2*)(st + 512 + 2 * (rl0 + ai * HALF + m * 16));
            const float mm = sq[0] * (1.0f / 1024.0f), var = fmaxf(sq[1] * (1.0f / 1024.0f) - mm * mm, 0.f); mu[ai][m] = mm; rs[ai][m] = __builtin_amdgcn_rsqf(var + 1e-5f); }
}
struct EpiSwiglu {
    static constexpr bool PERM = true, AFTER_DRAIN = false, STASH = true;
    bf16_t* H; const float* stat; const float* cs; const float* bw; PG8_LAS float* st;
    __device__ __forceinline__ void stash(const Unit& u, int wid, int lane) const { stash_unit(u, wid, lane, cs, bw, stat, st); }
    __device__ __forceinline__ void operator()(const f32x4 (&acc)[2][2][4][2], const Unit& u, int wr, int wc, int fr, int fq) const {
        const int row0 = u.pm * BM + wr * 64 + fr; const int cc = u.pn * BM + wc * 32 + 8 * fq; const int hc = u.pn * HALF + wc * 32 + 8 * fq;
        float mu[2][4], rs[2][4]; row_stats8_lds(st, wr * 64 + fr, mu, rs);
        const int lc = wc * 32 + 8 * fq;
        f32x4 csg[2], csu[2], bwg[2], bwu[2];
#pragma unroll
        for (int n = 0; n < 2; ++n) { csg[n] = *(const PG8_LAS f32x4*)(st + lc + 4 * n); csu[n] = *(const PG8_LAS f32x4*)(st + lc + HALF + 4 * n); bwg[n] = *(const PG8_LAS f32x4*)(st + 256 + lc + 4 * n); bwu[n] = *(const PG8_LAS f32x4*)(st + 256 + lc + HALF + 4 * n); }
#pragma unroll
        for (int ai = 0; ai < 2; ++ai)
#pragma unroll
            for (int m = 0; m < 4; ++m) { const int row = row0 + ai * HALF + m * 16; f32x4 hv[2];
#pragma unroll
                for (int n = 0; n < 2; ++n) { const f32x4 g = (acc[ai][0][m][n] - csg[n] * mu[ai][m]) * rs[ai][m] + bwg[n], up = (acc[ai][1][m][n] - csu[n] * mu[ai][m]) * rs[ai][m] + bwu[n];
                    const f32x4 t = g * -1.4426950408889634f; f32x4 e = (f32x4){__builtin_amdgcn_exp2f(t[0]), __builtin_amdgcn_exp2f(t[1]), __builtin_amdgcn_exp2f(t[2]), __builtin_amdgcn_exp2f(t[3])};
                    e = e + 1.0f; const f32x4 r = (f32x4){__builtin_amdgcn_rcpf(e[0]), __builtin_amdgcn_rcpf(e[1]), __builtin_amdgcn_rcpf(e[2]), __builtin_amdgcn_rcpf(e[3])};
                    hv[n] = (g * up) * r; }
                u32x4 w; w.x = cvt_pk_bf16(hv[0][0], hv[0][1]); w.y = cvt_pk_bf16(hv[0][2], hv[0][3]); w.z = cvt_pk_bf16(hv[1][0], hv[1][1]); w.w = cvt_pk_bf16(hv[1][2], hv[1][3]);
                *(u32x4*)(H + (size_t)row * 2816 + hc) = w; }
    }
};
struct EpiQKV {
    static constexpr bool PERM = true, AFTER_DRAIN = false, STASH = true;
    bf16_t* Q; size_t tstride; const float* stat; const float* cs; const float* bw; float qscale; PG8_LAS float* st;
    __device__ __forceinline__ void stash(const Unit& u, int wid, int lane) const { stash_unit(u, wid, lane, cs, bw, stat, st); }
    __device__ __forceinline__ void operator()(const f32x4 (&acc)[2][2][4][2], const Unit& u, int wr, int wc, int fr, int fq) const {
        const int row0 = u.pm * BM + wr * 64 + fr; const int cc = u.pn * BM + wc * 32 + 8 * fq;
        const int t = (u.pn * BM) >> 10; bf16_t* base = Q + (size_t)t * tstride; const int col0 = ((u.pn * BM) & 1023) + wc * 32 + 8 * fq; const float sc = (t == 0) ? qscale : 1.0f;
        float mu[2][4], rs[2][4]; row_stats8_lds(st, wr * 64 + fr, mu, rs);
        const int lc = wc * 32 + 8 * fq;
#pragma unroll
        for (int bj = 0; bj < 2; ++bj) { const f32x4 cs0 = *(const PG8_LAS f32x4*)(st + lc + bj * HALF), cs1 = *(const PG8_LAS f32x4*)(st + lc + bj * HALF + 4), bw0 = *(const PG8_LAS f32x4*)(st + 256 + lc + bj * HALF), bw1 = *(const PG8_LAS f32x4*)(st + 256 + lc + bj * HALF + 4);
#pragma unroll
            for (int ai = 0; ai < 2; ++ai)
#pragma unroll
                for (int m = 0; m < 4; ++m) { const int row = row0 + ai * HALF + m * 16;
                    const f32x4 v0 = ((acc[ai][bj][m][0] - cs0 * mu[ai][m]) * rs[ai][m] + bw0) * sc, v1 = ((acc[ai][bj][m][1] - cs1 * mu[ai][m]) * rs[ai][m] + bw1) * sc;
                    u32x4 w; w.x = cvt_pk_bf16(v0[0], v0[1]); w.y = cvt_pk_bf16(v0[2], v0[3]); w.z = cvt_pk_bf16(v1[0], v1[1]); w.w = cvt_pk_bf16(v1[2], v1[3]);
                    *(u32x4*)(base + (size_t)row * 1024 + col0 + bj * HALF) = w; } }
    }
};
struct EpiResid {
    static constexpr bool PERM = true, AFTER_DRAIN = false, STASH = false;
    _Float16* z; const float* stat_in; const PG8_LAS float* gb; float* stat_out; float coef;
    __device__ __forceinline__ void operator()(const f32x4 (&acc)[2][2][4][2], const Unit& u, int wr, int wc, int fr, int fq) const {
        constexpr float ALPHA = 1.681792830507429f;
        const int row0 = u.pm * BM + wr * 64 + fr; const int col0 = u.pn * BM + wc * 32 + 8 * fq;
#pragma unroll
        for (int ai = 0; ai < 2; ++ai) {
            f32x2 sq[4]; f16x8 hh[4][2];
#pragma unroll
            for (int m = 0; m < 4; ++m) { sq[m] = *(const f32x2*)(stat_in + 2 * (row0 + ai * HALF + m * 16));
#pragma unroll
                for (int bj = 0; bj < 2; ++bj) hh[m][bj] = *(const f16x8*)(z + (unsigned)(row0 + ai * HALF + m * 16) * 1024u + (unsigned)col0 + bj * HALF); }
            float tprev = 0.f;
#pragma unroll
            for (int m = 0; m < 4; ++m) { const int row = row0 + ai * HALF + m * 16; const unsigned off = (unsigned)row * 1024u + (unsigned)col0;
                const f16x8 (&h)[2] = hh[m];
                const float mu = sq[m][0] * (1.0f / 1024.0f), var = fmaxf(sq[m][1] * (1.0f / 1024.0f) - mu * mu, 0.f), rs = __builtin_amdgcn_rsqf(var + 1e-5f);
                float s = 0.f, q = 0.f;
#pragma unroll
                for (int bj = 0; bj < 2; ++bj) { f32x4 zn[2];
#pragma unroll
                    for (int n = 0; n < 2; ++n) { const f32x4 zr = (f32x4){(float)h[bj][4 * n], (float)h[bj][4 * n + 1], (float)h[bj][4 * n + 2], (float)h[bj][4 * n + 3]};
                        const f32x4 gv = *(const PG8_LAS f32x4*)(gb + col0 + bj * HALF + 4 * n), bv = *(const PG8_LAS f32x4*)(gb + 1024 + col0 + bj * HALF + 4 * n);
                        const f32x4 xn = (zr - mu) * rs * gv + bv;
                        zn[n] = xn * ALPHA + acc[ai][bj][m][n] * coef;
                        s += (zn[n][0] + zn[n][1]) + (zn[n][2] + zn[n][3]); q += (zn[n][0] * zn[n][0] + zn[n][1] * zn[n][1]) + (zn[n][2] * zn[n][2] + zn[n][3] * zn[n][3]); }
                    const f16x8 w = (f16x8){(_Float16)zn[0][0], (_Float16)zn[0][1], (_Float16)zn[0][2], (_Float16)zn[0][3], (_Float16)zn[1][0], (_Float16)zn[1][1], (_Float16)zn[1][2], (_Float16)zn[1][3]};
                    *(f16x8*)(z + off + bj * HALF) = w; }
                const bool odd = (fq & 1) != 0; float t = odd ? q : s; const float u = odd ? s : q;
                t += __shfl_xor(u, 16); t += __shfl_xor(t, 32);
                if (m & 1) { const int arow = row0 + ai * HALF + (m - 1 + (fq >> 1)) * 16; unsafeAtomicAdd(stat_out + 2 * arow + (fq & 1), (fq >> 1) ? t : tprev); }
                tprev = t; }
            asm volatile("" ::: "memory"); }
    }
};

template <class Epi, class Sched, bool ALIGN_EPI = false, bool SP2 = false, bool F16 = false>
__device__ __forceinline__ void gemm_phase(PG8_LAS unsigned char* lds, const int tid, const Gemm g, const Sched& S, const Epi& E) {
    const int  wid = __builtin_amdgcn_readfirstlane(tid >> 6), lane = tid & 63, wr = wid >> 2, wc = wid & 3, fr = lane & 15, fq = lane >> 4;
    const int K = g.K, nt = K / BK;
    unsigned voffA[2], voffB[2];
#pragma unroll
    for (int i = 0; i < 2; ++i) { int R, C; stage_rc(tid * 16 + i * 8192, R, C); const int Rb = Epi::PERM ? ((R & ~31) + perm32(R & 31)) : R;
        voffA[i] = (unsigned)(R * K + C) * 2u; voffB[i] = (unsigned)(Rb * K + C) * 2u; }
    const size_t kstep = (size_t)(BK * 2);
    const size_t hstep = (size_t)HALF * K * 2;
    const size_t tstep = 2 * hstep;
    const unsigned ldsw = (unsigned)wid * 1024u;
    const int aoff = lds_byte(wr * 64 + fr, fq * 8), boff = lds_byte(wc * 32 + fr, fq * 8);
#define PG8_SA(b, h) (((b) * 2 + (h)) * HTB)
#define PG8_SB(b, h) ((4 + (b) * 2 + (h)) * HTB)
#define PG8_STAGE(bufoff, gbase, voff) do { _Pragma("unroll") for (int _i = 0; _i < 2; ++_i) \
        __builtin_amdgcn_global_load_lds((const unsigned*)((const char*)(gbase) + (voff)[_i]), (PG8_LAS unsigned*)(lds + (bufoff) + ldsw + _i * 8192), 16, 0, 0); } while (0)
#define PG8_LDA(dst, b, h) do { _Pragma("unroll") for (int m = 0; m < 4; ++m) _Pragma("unroll") for (int k = 0; k < 2; ++k) dst[m][k] = *(const PG8_LAS bf16x8*)(lds + PG8_SA(b, h) + aoff + m * 2048 + k * 1024); } while (0)
#define PG8_LDB(dst, b, h) do { _Pragma("unroll") for (int n = 0; n < 2; ++n) _Pragma("unroll") for (int k = 0; k < 2; ++k) dst[n][k] = *(const PG8_LAS bf16x8*)(lds + PG8_SB(b, h) + boff + n * 2048 + k * 1024); } while (0)
#define PG8_MMA(ai, bj, At, Bt) do { __builtin_amdgcn_s_setprio(1); _Pragma("unroll") for (int m = 0; m < 4; ++m) _Pragma("unroll") for (int n = 0; n < 2; ++n) _Pragma("unroll") for (int k = 0; k < 2; ++k) \
        acc[ai][bj][m][n] = mma16<F16>(Bt[n][k], At[m][k], acc[ai][bj][m][n]); __builtin_amdgcn_s_setprio(0); } while (0)
#define PG8_WAIT_V(n) asm volatile("s_waitcnt vmcnt(" #n ")" ::: "memory")
#define PG8_WAIT_L(n) asm volatile("s_waitcnt lgkmcnt(" #n ")" ::: "memory")
#define PG8_BAR __builtin_amdgcn_s_barrier()
#define PG8_SCHED __builtin_amdgcn_sched_barrier(0)
    Unit cur, nxt; int ui = 0;
    if (!S.next(0, cur)) return;
    f32x4 acc[2][2][4][2];
#pragma unroll
    for (int a = 0; a < 2; ++a)
#pragma unroll
        for (int b = 0; b < 2; ++b)
#pragma unroll
            for (int m = 0; m < 4; ++m)
#pragma unroll
                for (int n = 0; n < 2; ++n) acc[a][b][m][n] = (f32x4){0.f, 0.f, 0.f, 0.f};
    bf16x8 At[4][2], B0[2][2], B1[2][2];
    const char* cA = (const char*)g.A + (size_t)cur.pm * tstep; const char* cB = (const char*)g.Bt + (size_t)cur.pn * tstep;
    S.a_ready(cur);
    if constexpr (SP2) {
        PG8_STAGE(PG8_SB(0, 0), cB, voffB); PG8_STAGE(PG8_SB(0, 1), cB + hstep, voffB); PG8_STAGE(PG8_SA(0, 0), cA, voffA); PG8_STAGE(PG8_SA(0, 1), cA + hstep, voffA);
        if (wr == 1) PG8_BAR;
        PG8_WAIT_V(2); PG8_BAR;
        PG8_STAGE(PG8_SB(1, 0), cB + kstep, voffB); PG8_STAGE(PG8_SA(1, 0), cA + kstep, voffA); PG8_STAGE(PG8_SB(1, 1), cB + hstep + kstep, voffB);
        PG8_WAIT_V(6); PG8_BAR;
    } else {
        PG8_STAGE(PG8_SB(0, 0), cB, voffB); PG8_STAGE(PG8_SA(0, 0), cA, voffA); PG8_STAGE(PG8_SB(0, 1), cB + hstep, voffB); PG8_STAGE(PG8_SA(0, 1), cA + hstep, voffA);
        if (wr == 1) PG8_BAR;
        PG8_WAIT_V(4); PG8_BAR;
        PG8_STAGE(PG8_SB(1, 0), cB + kstep, voffB); PG8_STAGE(PG8_SA(1, 0), cA + kstep, voffA); PG8_STAGE(PG8_SB(1, 1), cB + hstep + kstep, voffB);
        PG8_WAIT_V(6); PG8_BAR;
    }
    for (;;) {
        const bool has_next = S.next(ui + 1, nxt);
        const char* nA = has_next ? (const char*)g.A + (size_t)nxt.pm * tstep : cA; const char* nB = has_next ? (const char*)g.Bt + (size_t)nxt.pn * tstep : cB;
        for (int t = 0; t < nt; t += 2) {
            const bool last = (t == nt - 2);
            const char* a1 = cA + (size_t)(t + 1) * kstep;
            const char* a2 = last ? nA : cA + (size_t)(t + 2) * kstep; const char* b2 = last ? nB : cB + (size_t)(t + 2) * kstep;
            const char* a3 = a2 + kstep; const char* b3 = b2 + kstep;
            if (last && has_next) S.a_ready(nxt);
            if constexpr (Epi::STASH) { if (last) E.stash(cur, wid, lane); }
            if constexpr (SP2) {
            PG8_LDB(B0, 0, 0); PG8_LDB(B1, 0, 1); PG8_SCHED; PG8_LDA(At, 0, 0); PG8_STAGE(PG8_SA(1, 1), a1 + hstep, voffA);
            PG8_WAIT_V(8); PG8_WAIT_L(0); PG8_BAR; PG8_MMA(0, 0, At, B0); PG8_MMA(0, 1, At, B1); PG8_BAR; PG8_SCHED;
            PG8_LDA(At, 0, 1); PG8_STAGE(PG8_SB(0, 0), b2, voffB); PG8_STAGE(PG8_SB(0, 1), b2 + hstep, voffB); PG8_STAGE(PG8_SA(0, 0), a2, voffA);
            PG8_WAIT_V(8); PG8_WAIT_L(0); PG8_BAR; PG8_MMA(1, 0, At, B0); PG8_MMA(1, 1, At, B1); PG8_BAR; PG8_SCHED;
            PG8_LDB(B0, 1, 0); PG8_LDB(B1, 1, 1); PG8_SCHED; PG8_LDA(At, 1, 0); PG8_STAGE(PG8_SA(0, 1), a2 + hstep, voffA);
            PG8_WAIT_V(8); PG8_WAIT_L(0); PG8_BAR; PG8_MMA(0, 0, At, B0); PG8_MMA(0, 1, At, B1); PG8_BAR; PG8_SCHED;
            PG8_LDA(At, 1, 1); PG8_STAGE(PG8_SB(1, 0), b3, voffB); PG8_STAGE(PG8_SB(1, 1), b3 + hstep, voffB); PG8_STAGE(PG8_SA(1, 0), a3, voffA);
            PG8_WAIT_V(8); PG8_WAIT_L(0); PG8_BAR; PG8_MMA(1, 0, At, B0); PG8_MMA(1, 1, At, B1); PG8_BAR; PG8_SCHED;
            } else {
            PG8_LDB(B0, 0, 0); PG8_SCHED; PG8_LDA(At, 0, 0); PG8_STAGE(PG8_SA(1, 1), a1 + hstep, voffA);
            PG8_WAIT_L(8); PG8_BAR; PG8_WAIT_L(0); PG8_MMA(0, 0, At, B0); PG8_BAR; PG8_SCHED;
            PG8_LDB(B1, 0, 1); PG8_STAGE(PG8_SB(0, 0), b2, voffB);
            PG8_BAR; PG8_WAIT_L(0); PG8_MMA(0, 1, At, B1); PG8_BAR;
            PG8_LDA(At, 0, 1); PG8_STAGE(PG8_SA(0, 0), a2, voffA);
            PG8_BAR; PG8_WAIT_L(0); PG8_MMA(1, 0, At, B0); PG8_BAR; PG8_SCHED;
            PG8_STAGE(PG8_SB(0, 1), b2 + hstep, voffB);
            PG8_WAIT_V(6); PG8_BAR; PG8_MMA(1, 1, At, B1); PG8_BAR;
            PG8_LDB(B0, 1, 0); PG8_SCHED; PG8_LDA(At, 1, 0); PG8_STAGE(PG8_SA(0, 1), a2 + hstep, voffA);
            PG8_WAIT_L(8); PG8_BAR; PG8_WAIT_L(0); PG8_MMA(0, 0, At, B0); PG8_BAR; PG8_SCHED;
            PG8_LDB(B1, 1, 1); PG8_STAGE(PG8_SB(1, 0), b3, voffB);
            PG8_BAR; PG8_WAIT_L(0); PG8_MMA(0, 1, At, B1); PG8_BAR;
            PG8_LDA(At, 1, 1); PG8_STAGE(PG8_SA(1, 0), a3, voffA);
            PG8_BAR; PG8_WAIT_L(0); PG8_MMA(1, 0, At, B0); PG8_BAR; PG8_SCHED;
            PG8_STAGE(PG8_SB(1, 1), b3 + hstep, voffB);
            PG8_WAIT_V(6); PG8_BAR; PG8_MMA(1, 1, At, B1); PG8_BAR;
            }
        }
        if constexpr (ALIGN_EPI) { if (wr == 0) PG8_BAR; }
        if constexpr (!Epi::AFTER_DRAIN) { E(acc, cur, wr, wc, fr, fq); S.done(cur); }
        if (!has_next) break;
#pragma unroll
        for (int a = 0; a < 2; ++a)
#pragma unroll
            for (int b = 0; b < 2; ++b)
#pragma unroll
                for (int m = 0; m < 4; ++m)
#pragma unroll
                    for (int n = 0; n < 2; ++n) acc[a][b][m][n] = (f32x4){0.f, 0.f, 0.f, 0.f};
        cur = nxt; cA = nA; cB = nB; ++ui;
        if constexpr (ALIGN_EPI) { if (wr == 1) PG8_BAR; }
    }
    PG8_WAIT_V(0);
    if constexpr (!ALIGN_EPI) { if (wr == 0) PG8_BAR; }
    PG8_BAR;
    if constexpr (Epi::AFTER_DRAIN) { E.fused(acc, cur, wr, wc, fr, fq, lds, wid, lane); S.done(cur); }
#undef PG8_SA
#undef PG8_SB
#undef PG8_STAGE
#undef PG8_LDA
#undef PG8_LDB
#undef PG8_MMA
#undef PG8_WAIT_V
#undef PG8_WAIT_L
#undef PG8_BAR
#undef PG8_SCHED
}
}
namespace att {
#define ALAS __attribute__((address_space(3)))
typedef unsigned short bf16_t;
typedef short bf16x8 __attribute__((ext_vector_type(8)));
typedef short s16x4 __attribute__((ext_vector_type(4)));
typedef float f32x16 __attribute__((ext_vector_type(16)));
typedef unsigned u32x4 __attribute__((ext_vector_type(4)));
constexpr int DM = 1024, SEQ = 2048;
constexpr int VHALF = 4096;
constexpr int L_KV = 0;
constexpr int L_WSF = 65536;
constexpr int L_TAB = 65536 + 2048;
constexpr int L_OST = 65536 + 8192;
constexpr int L_FLAG = L_OST + 32768;
constexpr float LOG2E = 1.4426950408889634f;
__device__ __forceinline__ int crow(int r, int hi) { return (r & 3) + 8 * (r >> 2) + 4 * hi; }
__device__ __forceinline__ unsigned cvtpk(float lo, float hi) { unsigned r; asm volatile("v_cvt_pk_bf16_f32 %0, %1, %2" : "=v"(r) : "v"(lo), "v"(hi)); return r; }
typedef short v4i16_t __attribute__((ext_vector_type(4)));
__device__ __forceinline__ s16x4 vtr(const ALAS unsigned char* p) { return __builtin_bit_cast(s16x4, __builtin_amdgcn_ds_read_tr16_b64_v4i16((ALAS v4i16_t*)p)); }

struct Stage { u32x4 k[2], v[2]; };
__device__ __forceinline__ void stage_load(Stage& s, const bf16_t* Kg, const bf16_t* Vg, long tok0, int hcol, int t256) {
#pragma unroll
    for (int i = 0; i < 2; ++i) { const int cid = t256 + 256 * i, row = cid >> 3, ch = cid & 7; const size_t o = (size_t)(tok0 + row) * DM + hcol + ch * 8;
        s.k[i] = *(const u32x4*)(Kg + o); s.v[i] = *(const u32x4*)(Vg + o); }
}
__device__ __forceinline__ void stage_store(const Stage& s, ALAS unsigned char* kbuf, ALAS unsigned char* vbuf, int t256) {
#pragma unroll
    for (int i = 0; i < 2; ++i) { const int cid = t256 + 256 * i, row = cid >> 3, ch = cid & 7;
        *(ALAS u32x4*)(kbuf + row * 128 + ((ch ^ ((row >> 1) & 7)) << 4)) = s.k[i];
        *(ALAS u32x4*)(vbuf + (ch >> 2) * VHALF + row * 64 + (ch & 3) * 16) = s.v[i]; }
}
__device__ __forceinline__ void qk_tile(f32x16& p0, f32x16& p1, const ALAS unsigned char* kbuf, const bf16x8 (&qr)[4], int r32, int hi, const f32x16& cinit) {
    const int sw = (r32 >> 1) & 7;
#pragma unroll
    for (int d0 = 0; d0 < 4; ++d0) { const int ch = 2 * d0 + hi;
        const bf16x8 a0 = *(const ALAS bf16x8*)(kbuf + r32 * 128 + ((ch ^ sw) << 4));
        const bf16x8 a1 = *(const ALAS bf16x8*)(kbuf + (r32 + 32) * 128 + ((ch ^ sw) << 4));
        p0 = __builtin_amdgcn_mfma_f32_32x32x16_bf16(a0, qr[d0], d0 == 0 ? cinit : p0, 0, 0, 0);
        p1 = __builtin_amdgcn_mfma_f32_32x32x16_bf16(a1, qr[d0], d0 == 0 ? cinit : p1, 0, 0, 0); }
}
__device__ __forceinline__ float max3f(float a, float b, float c) { float r; asm("v_max3_f32 %0, %1, %2, %3" : "=v"(r) : "v"(a), "v"(b), "v"(c)); return r; }
__device__ __forceinline__ void pv_tile(f32x16 (&o)[2], const ALAS unsigned char* vbuf, const f32x16& p0, const f32x16& p1, int lane, int hi) {
    u32x4 pw[4];
#pragma unroll
    for (int k = 0; k < 2; ++k) { pw[k] = (u32x4){cvtpk(p0[8 * k + 0], p0[8 * k + 1]), cvtpk(p0[8 * k + 2], p0[8 * k + 3]), cvtpk(p0[8 * k + 4], p0[8 * k + 5]), cvtpk(p0[8 * k + 6], p0[8 * k + 7])};
        pw[2 + k] = (u32x4){cvtpk(p1[8 * k + 0], p1[8 * k + 1]), cvtpk(p1[8 * k + 2], p1[8 * k + 3]), cvtpk(p1[8 * k + 4], p1[8 * k + 5]), cvtpk(p1[8 * k + 6], p1[8 * k + 7])}; }
    const ALAS unsigned char* vp = vbuf + ((lane >> 4) & 1) * 32 + (lane & 3) * 8 + (4 * hi + ((lane & 15) >> 2)) * 64;
#pragma unroll
    for (int d0 = 0; d0 < 2; ++d0)
#pragma unroll
        for (int ks = 0; ks < 4; ++ks) { const s16x4 lo = vtr(vp + d0 * VHALF + ks * 1024), hh = vtr(vp + d0 * VHALF + ks * 1024 + 512);
            const bf16x8 vb = (bf16x8){lo[0], lo[1], lo[2], lo[3], hh[0], hh[1], hh[2], hh[3]};
            o[d0] = __builtin_amdgcn_mfma_f32_32x32x16_bf16(__builtin_bit_cast(bf16x8, pw[ks]), vb, o[d0], 0, 0, 0); }
}
__device__ __forceinline__ void store_o(const f32x16 (&o)[2], ALAS unsigned char* lds, int wid, int lane, int r32, int hi, bf16_t* Og  , bool scaled) {
    ALAS float* wsf = (ALAS float*)(lds + L_WSF) + wid * 64;
    ALAS bf16_t* stg = (ALAS bf16_t*)(lds + L_OST) + wid * 2048;
#pragma unroll
    for (int r = 0; r < 16; ++r) { const int orow = crow(r, hi); const float sc = scaled ? wsf[orow] : 1.0f;
#pragma unroll
        for (int d0 = 0; d0 < 2; ++d0) { const unsigned w = cvtpk(o[d0][r] * sc, 0.f); stg[orow * 64 + d0 * 32 + r32] = (bf16_t)(w & 0xffffu); } }
    asm volatile("s_waitcnt lgkmcnt(0)" ::: "memory");
#pragma unroll
    for (int i = 0; i < 4; ++i) { const int row = i * 8 + (lane >> 3), ch = lane & 7; const u32x4 v = *(const ALAS u32x4*)(stg + row * 64 + ch * 8); *(u32x4*)(Og + (size_t)row * DM + ch * 8) = v; }
    asm volatile("s_waitcnt lgkmcnt(0)" ::: "memory");
}

__device__ __forceinline__ void chunk_prefetch(int b, int hp, int qblk, const bf16_t* Q, const bf16_t* K, const bf16_t* V, bf16x8 (&qn)[4], Stage& Sn, u32x4 (&k1n)[2], const int tid) {
    const int lane = tid & 63, r32 = lane & 31, hi = lane >> 5, wid = __builtin_amdgcn_readfirstlane(tid >> 6), half = wid >> 2, w4 = wid & 3, t256 = tid & 255;
    const int hcol = (2 * hp + half) * 64; const long tokb = (long)b * SEQ;
    const int cq = 2 * qblk + (w4 >> 1), tq0 = cq * 64 + (w4 & 1) * 32, kc_lo = (2 * qblk - 8) > 0 ? (2 * qblk - 8) : 0;
#pragma unroll
    for (int d0 = 0; d0 < 4; ++d0) qn[d0] = *(const bf16x8*)(Q + (size_t)(tokb + tq0 + r32) * DM + hcol + d0 * 16 + hi * 8);
    stage_load(Sn, K, V, tokb + (long)kc_lo * 64, hcol, t256);
#pragma unroll
    for (int i = 0; i < 2; ++i) { const int cid = t256 + 256 * i, row = cid >> 3, ch = cid & 7; k1n[i] = *(const u32x4*)(K + (size_t)(tokb + (long)(kc_lo + 1) * 64 + row) * DM + hcol + ch * 8); }
}
__device__ __forceinline__ void stage_load_kv(Stage& s, const bf16_t* Kg, const bf16_t* Vg, long tokK, long tokV, int hcol, int t256) {
#pragma unroll
    for (int i = 0; i < 2; ++i) { const int cid = t256 + 256 * i, row = cid >> 3, ch = cid & 7;
        s.k[i] = *(const u32x4*)(Kg + (size_t)(tokK + row) * DM + hcol + ch * 8); s.v[i] = *(const u32x4*)(Vg + (size_t)(tokV + row) * DM + hcol + ch * 8); }
}
__device__ __forceinline__ void store_k(const u32x4 (&k)[2], ALAS unsigned char* kbuf, int t256) {
#pragma unroll
    for (int i = 0; i < 2; ++i) { const int cid = t256 + 256 * i, row = cid >> 3, ch = cid & 7; *(ALAS u32x4*)(kbuf + row * 128 + ((ch ^ ((row >> 1) & 7)) << 4)) = k[i]; }
}
__device__ __forceinline__ void chunk_attn_unit(int b, int hp, int qblk, int qblk_next, bf16x8 (&qn)[4], Stage& Sn, u32x4 (&k1n)[2], const bf16_t* Q, const bf16_t* K, const bf16_t* V, bf16_t* O, const float* rel, ALAS unsigned char* lds, const int tid) {
    const int lane = tid & 63, r32 = lane & 31, hi = lane >> 5, wid = __builtin_amdgcn_readfirstlane(tid >> 6), half = wid >> 2, w4 = wid & 3, t256 = tid & 255;
    const int h = 2 * hp + half, hcol = h * 64; const long tokb = (long)b * SEQ;
    const int cq = 2 * qblk + (w4 >> 1), iq0 = (w4 & 1) * 32, tq0 = cq * 64 + iq0;
    ALAS float* wsf = (ALAS float*)(lds + L_WSF) + wid * 64;
    ALAS float* tab = (ALAS float*)(lds + L_TAB) + half * 260;
    bf16x8 qr[4];
#pragma unroll
    for (int d0 = 0; d0 < 4; ++d0) qr[d0] = qn[d0];
    for (int i = t256; i < 257; i += 256) tab[i] = rel[i * 16 + h] * LOG2E;
    const int kc_lo = (2 * qblk - 8) > 0 ? (2 * qblk - 8) : 0, n = 2 * qblk + 1 - kc_lo + 1;
#define ATT_KB(x) (lds + L_KV + (((x) * 2 + half) * 2 + 0) * 8192)
#define ATT_VB(x) (lds + L_KV + (((x) * 2 + half) * 2 + 1) * 8192)
#define ATT_TOK(j) (tokb + (long)(kc_lo + (j)) * 64)
    Stage S0 = Sn, S1;
    store_k(S0.k, ATT_KB(1), t256);
    S0.k[0] = k1n[0]; S0.k[1] = k1n[1];
    stage_store(S0, ATT_KB(0), ATT_VB(0), t256);
    if (n > 1) stage_load_kv(S0, K, V, ATT_TOK(2 < n ? 2 : n - 1), ATT_TOK(1), hcol, t256);
    if (n > 2) stage_load_kv(S1, K, V, ATT_TOK(3 < n ? 3 : n - 1), ATT_TOK(2), hcol, t256);
    __syncthreads();
    float mrun = -INFINITY, lrun = 0.f; f32x16 o[2]; o[0] = (f32x16){}; o[1] = (f32x16){};
    const f32x16 zero16 = {}; f32x16 bcv; { const float bc = tab[256];
#pragma unroll
        for (int r = 0; r < 16; ++r) bcv[r] = bc; }
    auto active = [&](const int j) __attribute__((always_inline)) { const int kc = kc_lo + j; return kc >= cq - 8 && kc <= cq; };
    auto issue_qk = [&](const int j, const ALAS unsigned char* kbuf, f32x16& P0, f32x16& P1) __attribute__((always_inline)) {
        if (cq - (kc_lo + j) >= 3) qk_tile(P0, P1, kbuf, qr, r32, hi, bcv);
        else qk_tile(P0, P1, kbuf, qr, r32, hi, zero16); };
    auto softmax_pv = [&](const int j, const ALAS unsigned char* vbuf, f32x16& p0, f32x16& p1) __attribute__((always_inline)) {
        const int delta = cq - (kc_lo + j);
        if (delta < 3) { const int base = delta * 64 + iq0 + r32 + 128;
#pragma unroll
            for (int r = 0; r < 16; ++r) { const int i0 = base - crow(r, hi), i1 = i0 - 32; p0[r] += tab[i0 > 256 ? 256 : i0]; p1[r] += tab[i1 > 256 ? 256 : i1]; } }
        float mx = max3f(p0[0], p1[0], p0[1]);
#pragma unroll
        for (int r = 1; r < 15; ++r) mx = max3f(mx, p1[r], p0[r + 1]);
        mx = fmaxf(mx, p1[15]);
        mx = fmaxf(mx, __shfl_xor(mx, 32));
        const float mn = fmaxf(mrun, mx), f = __builtin_amdgcn_exp2f(mrun - mn); mrun = mn;
#pragma unroll
        for (int r = 0; r < 16; ++r) { p0[r] = __builtin_amdgcn_exp2f(p0[r] - mn); p1[r] = __builtin_amdgcn_exp2f(p1[r] - mn); }
        const f32x16 ps = p0 + p1;
        float rs = ((ps[0] + ps[1]) + (ps[2] + ps[3])) + ((ps[4] + ps[5]) + (ps[6] + ps[7])) + (((ps[8] + ps[9]) + (ps[10] + ps[11])) + ((ps[12] + ps[13]) + (ps[14] + ps[15])));
        rs += __shfl_xor(rs, 32);
        lrun = lrun * f + rs;
        if (__any(f != 1.0f)) { if (hi == 0) wsf[r32] = f; asm volatile("s_waitcnt lgkmcnt(0)" ::: "memory");
#pragma unroll
            for (int r = 0; r < 16; ++r) { const float ff = wsf[crow(r, hi)]; o[0][r] *= ff; o[1][r] *= ff; }
            asm volatile("s_waitcnt lgkmcnt(0)" ::: "memory"); }
        pv_tile(o, vbuf, p0, p1, lane, hi); };
    f32x16 p0, p1, pn0, pn1;
    if (active(0)) issue_qk(0, ATT_KB(1), p0, p1);
    __syncthreads();
#define ATT_STEP(ii, bufc, SX) do { \
        if ((ii) + 1 < n && active((ii) + 1)) issue_qk((ii) + 1, ATT_KB(bufc), pn0, pn1); \
        if (active(ii)) softmax_pv((ii), ATT_VB(bufc), p0, p1); \
        p0 = pn0; p1 = pn1; \
        if ((ii) + 1 < n) stage_store(SX, ATT_KB((bufc) ^ 1), ATT_VB((bufc) ^ 1), t256); \
        if ((ii) + 3 < n) stage_load_kv(SX, K, V, ATT_TOK((ii) + 4 < n ? (ii) + 4 : n - 1), ATT_TOK((ii) + 3), hcol, t256); \
        __syncthreads(); } while (0)
    for (int i = 0; i < n; i += 2) { ATT_STEP(i, 0, S0); if (i + 1 < n) ATT_STEP(i + 1, 1, S1); }
#undef ATT_STEP
#undef ATT_KB
#undef ATT_VB
#undef ATT_TOK
    if (qblk_next >= 0) chunk_prefetch(b, hp, qblk_next, Q, K, V, qn, Sn, k1n, tid);
    if (hi == 0) wsf[r32] = 1.0f / lrun;
    asm volatile("s_waitcnt lgkmcnt(0)" ::: "memory");
    store_o(o, lds, wid, lane, r32, hi, O + (size_t)(tokb + tq0) * DM + hcol, true);
}

__device__ __forceinline__ void stick_prefetch(int b, int hp, int qb, const bf16_t* Q, const bf16_t* K, const bf16_t* V, bf16x8 (&qn)[4], Stage& Sn, const int tid) {
    const int lane = tid & 63, r32 = lane & 31, hi = lane >> 5, wid = __builtin_amdgcn_readfirstlane(tid >> 6), half = wid >> 2, w4 = wid & 3, t256 = tid & 255;
    const int hcol = (2 * hp + half) * 64; const long tokb = (long)b * SEQ; const int tq = qb * 128 + w4 * 32 + r32, n = 2 * qb + 2;
#pragma unroll
    for (int d0 = 0; d0 < 4; ++d0) qn[d0] = *(const bf16x8*)(Q + (size_t)(tokb + tq) * DM + hcol + d0 * 16 + hi * 8);
    stage_load(Sn, K, V, tokb + (long)(n - 1) * 64, hcol, t256);
}
__device__ __forceinline__ void stick_attn_unit(int b, int hp, int qb, int qb_next, bf16x8 (&qn)[4], Stage& Sn, const bf16_t* Q, const bf16_t* K, const bf16_t* V, bf16_t* O, ALAS unsigned char* lds, const int tid) {
    const int lane = tid & 63, r32 = lane & 31, hi = lane >> 5, wid = __builtin_amdgcn_readfirstlane(tid >> 6), half = wid >> 2, w4 = wid & 3, t256 = tid & 255;
    const int h = 2 * hp + half, hcol = h * 64; const long tokb = (long)b * SEQ;
    const int tq0 = qb * 128 + w4 * 32, tq = tq0 + r32;
    ALAS unsigned* flg = (ALAS unsigned*)(lds + L_FLAG);
    bf16x8 qr[4];
#pragma unroll
    for (int d0 = 0; d0 < 4; ++d0) qr[d0] = qn[d0];
    const int n = 2 * qb + 2;
    Stage S0 = Sn, S1;
    stage_store(S0, lds + L_KV + ((0 * 2 + half) * 2 + 0) * 8192, lds + L_KV + ((0 * 2 + half) * 2 + 1) * 8192, t256);
    stage_load(S0, K, V, tokb + (long)(n - 2) * 64, hcol, t256);
    if (n > 2) stage_load(S1, K, V, tokb + (long)(n - 3) * 64, hcol, t256);
    __syncthreads();
    float carry = 0.f; f32x16 o[2]; o[0] = (f32x16){}; o[1] = (f32x16){};
    auto compute = [&](const int i, const int bufc) __attribute__((always_inline)) { const int kt = n - 1 - i, k0 = kt * 64;
        if (k0 < tq0 + 31) {
            const ALAS unsigned char* kbuf = lds + L_KV + ((bufc * 2 + half) * 2 + 0) * 8192; const ALAS unsigned char* vbuf = kbuf + 8192;
            f32x16 p0, p1; { const f32x16 zero16 = {}; qk_tile(p0, p1, kbuf, qr, r32, hi, zero16); }
            const bool needmask = (k0 + 63 >= tq0);
            f32x16 L0, L1;
#pragma unroll
            for (int r = 0; r < 16; ++r) {
                { const float zz = p0[r], e = __builtin_amdgcn_exp2f(-fabsf(zz)), lsp = __builtin_amdgcn_logf(1.0f + e); float lb = fminf(zz, 0.f) - lsp, l1 = lb - zz;
                  if (needmask && (k0 + crow(r, hi) >= tq)) { lb = -INFINITY; l1 = 0.f; } p0[r] = lb; L0[r] = l1; }
                { const float zz = p1[r], e = __builtin_amdgcn_exp2f(-fabsf(zz)), lsp = __builtin_amdgcn_logf(1.0f + e); float lb = fminf(zz, 0.f) - lsp, l1 = lb - zz;
                  if (needmask && (k0 + 32 + crow(r, hi) >= tq)) { lb = -INFINITY; l1 = 0.f; } p1[r] = lb; L1[r] = l1; }
            }
            float g0[4], g1[4], pg0[4], pg1[4];
#pragma unroll
            for (int g = 0; g < 4; ++g) { g0[g] = (L0[4 * g] + L0[4 * g + 1]) + (L0[4 * g + 2] + L0[4 * g + 3]); g1[g] = (L1[4 * g] + L1[4 * g + 1]) + (L1[4 * g + 2] + L1[4 * g + 3]); }
#pragma unroll
            for (int g = 0; g < 4; ++g) { pg0[g] = __shfl_xor(g0[g], 32); pg1[g] = __shfl_xor(g1[g], 32); }
            float suff = 0.f;
#pragma unroll
            for (int g = 3; g >= 0; --g) { const float e3 = carry + suff + (hi == 0 ? pg1[g] : 0.f), e2 = e3 + L1[4 * g + 3], e1 = e2 + L1[4 * g + 2], e0 = e1 + L1[4 * g + 1];
                p1[4 * g + 3] = __builtin_amdgcn_exp2f(p1[4 * g + 3] + e3); p1[4 * g + 2] = __builtin_amdgcn_exp2f(p1[4 * g + 2] + e2);
                p1[4 * g + 1] = __builtin_amdgcn_exp2f(p1[4 * g + 1] + e1); p1[4 * g + 0] = __builtin_amdgcn_exp2f(p1[4 * g + 0] + e0);
                suff += g1[g] + pg1[g]; }
            carry += suff; suff = 0.f;
#pragma unroll
            for (int g = 3; g >= 0; --g) { const float e3 = carry + suff + (hi == 0 ? pg0[g] : 0.f), e2 = e3 + L0[4 * g + 3], e1 = e2 + L0[4 * g + 2], e0 = e1 + L0[4 * g + 1];
                p0[4 * g + 3] = __builtin_amdgcn_exp2f(p0[4 * g + 3] + e3); p0[4 * g + 2] = __builtin_amdgcn_exp2f(p0[4 * g + 2] + e2);
                p0[4 * g + 1] = __builtin_amdgcn_exp2f(p0[4 * g + 1] + e1); p0[4 * g + 0] = __builtin_amdgcn_exp2f(p0[4 * g + 0] + e0);
                suff += g0[g] + pg0[g]; }
            carry += suff;
            pv_tile(o, vbuf, p0, p1, lane, hi);
        }
    };
    bool stop = false;
#define ATT_STEP(ii, bufc, SX) do { compute((ii), (bufc)); \
        { const int alld = __all(carry < -150.0f); if (lane == 0) flg[(bufc) * 8 + wid] = (unsigned)alld; } \
        if ((ii) + 1 < n) stage_store(SX, lds + L_KV + ((((bufc) ^ 1) * 2 + half) * 2 + 0) * 8192, lds + L_KV + ((((bufc) ^ 1) * 2 + half) * 2 + 1) * 8192, t256); \
        if ((ii) + 3 < n) stage_load(SX, K, V, tokb + (long)(n - 1 - ((ii) + 3)) * 64, hcol, t256); \
        __syncthreads(); \
        { const ALAS u32x4* fp = (const ALAS u32x4*)(flg + (bufc) * 8); const u32x4 f0 = fp[0], f1 = fp[1]; \
          stop = (f0[0] & f0[1] & f0[2] & f0[3] & f1[0] & f1[1] & f1[2] & f1[3]) != 0u; } } while (0)
    for (int i = 0; i < n; i += 2) { ATT_STEP(i, 0, S0); if (stop) break; if (i + 1 < n) { ATT_STEP(i + 1, 1, S1); if (stop) break; } }
#undef ATT_STEP
    if (qb_next >= 0) stick_prefetch(b, hp, qb_next, Q, K, V, qn, Sn, tid);
    store_o(o, lds, wid, lane, r32, hi, O + (size_t)(tokb + tq0) * DM + hcol, false);
}
#undef ALAS
}

#define GAS __attribute__((address_space(1)))
#define LAS __attribute__((address_space(3)))
typedef unsigned short bf16;
typedef unsigned v4u __attribute__((ext_vector_type(4)));
typedef float f32x4 __attribute__((ext_vector_type(4)));
typedef short bf16x8 __attribute__((ext_vector_type(8)));
typedef GAS unsigned gu32;
typedef GAS unsigned long long gu64;
#define RLX_AGENT __ATOMIC_RELAXED, __HIP_MEMORY_SCOPE_AGENT
#define LDS_WAIT() asm volatile("s_waitcnt lgkmcnt(0)" ::: "memory")
#define VM_WAIT() asm volatile("s_waitcnt vmcnt(0)" ::: "memory")
__device__ __forceinline__ unsigned long long rt() { return __builtin_amdgcn_s_memrealtime(); }
__device__ __forceinline__ unsigned f2bf(float f) { unsigned u = __builtin_bit_cast(unsigned, f); return (u + 0x7fffu + ((u >> 16) & 1u)) >> 16; }
__device__ __forceinline__ unsigned pk2(float lo, float hi) { return f2bf(lo) | (f2bf(hi) << 16); }

#define XB_TMO      128
#define XB_XCNT(j)  (256  + 64 * (j))
#define XB_XSUB(j)  (1280 + 64 * (j))
#define XB_XGEN(j)  (2304 + 64 * (j))
#define XB_TOP      3328
#define XB_TOPGEN   3392
#define XCD_BAR_WORDS 3456
#define XB_SPIN_CAP (1u << 18)

__device__ __forceinline__ unsigned xb_ld(unsigned* p)              { return __hip_atomic_load(p, __ATOMIC_RELAXED, __HIP_MEMORY_SCOPE_AGENT); }
__device__ __forceinline__ unsigned xb_add(unsigned* p, unsigned v) { return __hip_atomic_fetch_add(p, v, __ATOMIC_RELAXED, __HIP_MEMORY_SCOPE_AGENT); }
__device__ __forceinline__ unsigned xb_xcc_id() { return (unsigned)__builtin_amdgcn_s_getreg((3 << 11) | 20) & 0xFu; }
#define XB_SPIN(cond, bar) do { unsigned _sp = 0; while (cond) { __builtin_amdgcn_s_sleep(1); \
    if ((++_sp & 255u) == 0u) { if (xb_ld(&(bar)[XB_TMO])) break; if (_sp > XB_SPIN_CAP) { atomicAdd(&(bar)[XB_TMO], 1u); break; } } } } while (0)

struct XcdBarrier {
    unsigned* bar; unsigned x;
    volatile LAS unsigned* st;
};

__device__ __forceinline__ XcdBarrier xcd_barrier_post(unsigned* bar, volatile LAS unsigned* st) {
    XcdBarrier b; b.bar = bar; b.x = xb_xcc_id(); b.st = st;
    if (threadIdx.x == 0) (void)xb_add(&bar[XB_XCNT(b.x)], 1u);
    return b;
}
__device__ __forceinline__ void xcd_barrier_complete(unsigned* bar, unsigned x, unsigned& nloc, unsigned& nx) {
    const unsigned G = gridDim.x * gridDim.y * gridDim.z;
    unsigned sum, cnt, mine, sp = 0u;
    for (;;) {
        sum = 0u; cnt = 0u; mine = 0u;
#pragma unroll
        for (unsigned j = 0; j < 16; ++j) { const unsigned c = xb_ld(&bar[XB_XCNT(j)]); sum += c; cnt += (c > 0u) ? 1u : 0u; mine = (j == x) ? c : mine; }
        if (sum == G) break;
        __builtin_amdgcn_s_sleep(1);
        if ((++sp & 255u) == 0u) { if (xb_ld(&bar[XB_TMO])) break; if (sp > XB_SPIN_CAP) { atomicAdd(&bar[XB_TMO], 1u); break; } }
    }
    nloc = mine > 0u ? mine : 1u; nx = cnt > 0u ? cnt : 1u;
}

__device__ __forceinline__ void xcd_barrier(const XcdBarrier& b) {
    asm volatile("s_waitcnt vmcnt(0)" ::: "memory");
    __syncthreads();
    if (threadIdx.x == 0) {
        unsigned* bar = b.bar;
        __builtin_amdgcn_s_waitcnt(0);
        unsigned nloc = b.st[0], nx = b.st[1];
        if (nloc == 0u) { xcd_barrier_complete(bar, b.x, nloc, nx); b.st[0] = nloc; b.st[1] = nx; }
        const unsigned old = xb_add(&bar[XB_XSUB(b.x)], 1u);
        const unsigned gen = old / nloc;
        if (old + 1u == (gen + 1u) * nloc) {
            __builtin_amdgcn_fence(__ATOMIC_RELEASE, "agent");
            asm volatile("s_waitcnt vmcnt(0)" ::: "memory");
            const unsigned og = xb_add(&bar[XB_TOP], 1u);
            const unsigned tg = og / nx;
            if (og + 1u == (tg + 1u) * nx) xb_add(&bar[XB_TOPGEN], 1u);
            else XB_SPIN(xb_ld(&bar[XB_TOPGEN]) == tg, bar);
            __builtin_amdgcn_fence(__ATOMIC_ACQUIRE, "agent");
            xb_add(&bar[XB_XGEN(b.x)], 1u);
            asm volatile("s_waitcnt vmcnt(0)" ::: "memory");
        } else {
            XB_SPIN(xb_ld(&bar[XB_XGEN(b.x)]) == gen, bar);
            __builtin_amdgcn_fence(__ATOMIC_ACQUIRE, "agent");
            asm volatile("s_waitcnt vmcnt(0)" ::: "memory");
        }
    }
    __syncthreads();
}
constexpr int NWAVES = 8;
constexpr int BATCH = 16, SEQ = 2048, D = 1024, FF = 2816, DEPTH = 4, M = BATCH * SEQ;
constexpr size_t MiB = 1u << 20;
constexpr size_t WS_CTL = 0, CTL_ZERO_BYTES = 4 * MiB;
constexpr int CW_BAR = 1024;
constexpr size_t WS_CS = 64 * 1024, WS_BW = 320 * 1024;
constexpr int CSV_QKV = 8 * 2 * FF;
constexpr size_t WS_IDSTAT = 640 * 1024;
constexpr size_t WS_STAT = 1 * MiB;
constexpr size_t WS_W1 = 4 * MiB;
constexpr size_t WS_W2 = WS_W1 + 88 * MiB;
constexpr size_t WS_WQKV = WS_W2 + 44 * MiB;
constexpr size_t WS_WO = WS_WQKV + 24 * MiB;
constexpr size_t WS_ZB = WS_WO + 8 * MiB;
constexpr size_t WS_QKV = WS_ZB + 64 * MiB;
constexpr size_t WS_Z16 = WS_QKV + 192 * MiB;
constexpr size_t WS_END = WS_Z16 + 64 * MiB;
constexpr int LDS_STAGE = 131072, GB_OFF = LDS_STAGE, MISC_OFF = GB_OFF + 8192, STASH_OFF = MISC_OFF + 512, ULIST_OFF = STASH_OFF + 4096, LDS_BYTES = ULIST_OFF + 1024;


typedef _Float16 h2_t __attribute__((ext_vector_type(2)));
__device__ __forceinline__ unsigned pk2h(float lo, float hi) { const h2_t h = (h2_t){(_Float16)lo, (_Float16)hi}; return __builtin_bit_cast(unsigned, h); }
__device__ __forceinline__ void transpose_item(const float* W, int N, bf16* WT, int Kt, int k0, int n0, int dst_row0, const float* gvec, const float* bvec, float* cs, float* bw, LAS float* scr, int lane, const bool f16out) {
    float csp[4] = {0.f, 0.f, 0.f, 0.f}, bwp[4] = {0.f, 0.f, 0.f, 0.f};
    const int c4 = lane & 7, kq = lane >> 3;
    f32x4 wv[8]; float gk[8], bk[8];
#pragma unroll
    for (int i = 0; i < 8; ++i) wv[i] = *(const f32x4*)(W + (size_t)(k0 + 8 * i + kq) * N + n0 + 4 * c4);
    if (gvec) {
#pragma unroll
        for (int i = 0; i < 8; ++i) { gk[i] = gvec[k0 + 8 * i + kq]; bk[i] = bvec[k0 + 8 * i + kq]; }
    } else {
#pragma unroll
        for (int i = 0; i < 8; ++i) { gk[i] = 1.0f; bk[i] = 0.0f; }
    }
#pragma unroll
    for (int i = 0; i < 8; ++i) { const int kk = 8 * i + kq;
#pragma unroll
        for (int j = 0; j < 4; ++j) { const float wsc = wv[i][j] * gk[i]; scr[kk * 33 + 4 * c4 + j] = wsc; csp[j] += f16out ? (float)(_Float16)wsc : __builtin_bit_cast(float, f2bf(wsc) << 16); bwp[j] += bk[i] * wv[i][j]; } }
    if (cs) {
#pragma unroll
        for (int j = 0; j < 4; ++j) { csp[j] += __shfl_xor(csp[j], 8); csp[j] += __shfl_xor(csp[j], 16); csp[j] += __shfl_xor(csp[j], 32); bwp[j] += __shfl_xor(bwp[j], 8); bwp[j] += __shfl_xor(bwp[j], 16); bwp[j] += __shfl_xor(bwp[j], 32); }
        if (lane < 8) {
#pragma unroll
            for (int j = 0; j < 4; ++j) { unsafeAtomicAdd(cs + dst_row0 + 4 * c4 + j, csp[j]); unsafeAtomicAdd(bw + dst_row0 + 4 * c4 + j, bwp[j]); } } }
    LDS_WAIT(); asm volatile("" ::: "memory");
    const int c = lane & 7;
#pragma unroll
    for (int j = 0; j < 4; ++j) { const int n = (lane >> 3) + 8 * j; const LAS float* s = scr + (8 * c) * 33 + n;
        v4u o; if (f16out) { o.x = pk2h(s[0 * 33], s[1 * 33]); o.y = pk2h(s[2 * 33], s[3 * 33]); o.z = pk2h(s[4 * 33], s[5 * 33]); o.w = pk2h(s[6 * 33], s[7 * 33]); }
        else { o.x = pk2(s[0 * 33], s[1 * 33]); o.y = pk2(s[2 * 33], s[3 * 33]); o.z = pk2(s[4 * 33], s[5 * 33]); o.w = pk2(s[6 * 33], s[7 * 33]); }
        *(v4u*)(WT + (size_t)(dst_row0 + n) * Kt + k0 + 8 * c) = o; }
    LDS_WAIT(); asm volatile("" ::: "memory");
}
__device__ __forceinline__ float wave_sum(float v) {
#pragma unroll
    for (int o = 1; o < 64; o <<= 1) v += __shfl_xor(v, o);
    return v;
}

#ifndef PROBE_GROUP
#define PROBE_GROUP 0
#endif
#define PROBE_T0(grp) unsigned long long pt0_ = 0; if (PROBE_GROUP == (grp)) pt0_ = __builtin_amdgcn_s_memrealtime();
#define PROBE_T1(grp) if (PROBE_GROUP == (grp)) { const unsigned long long pt1_ = __builtin_amdgcn_s_memrealtime(); while (__builtin_amdgcn_s_memrealtime() - pt1_ < pt1_ - pt0_) __builtin_amdgcn_s_sleep(8); }
#ifndef GEMM_F16
#define GEMM_F16 true
#endif
struct Args { const float* in[11]; float* out; unsigned char* ws; };

__global__ void __launch_bounds__(NWAVES * 64, 2) fwd_megakernel(Args args) {
    extern __shared__ __attribute__((aligned(16))) unsigned char lds_raw[];
    LAS unsigned char* lds = (LAS unsigned char*)lds_raw;
    volatile LAS unsigned* MISC = (volatile LAS unsigned*)(lds + MISC_OFF);
    const int wave = __builtin_amdgcn_readfirstlane(threadIdx.x >> 6);
    const int G = gridDim.x, bx = blockIdx.x;
    unsigned char* ws = args.ws;
    unsigned* ctl = (unsigned*)(ws + WS_CTL);
    const float* x_in = args.in[0]; const float* rel = args.in[3]; const float* ln_g = args.in[9]; const float* ln_b = args.in[10];
    float* zout = args.out;
    float* IDSTAT = (float*)(ws + WS_IDSTAT);
    float* CS = (float*)(ws + WS_CS); float* BW = (float*)(ws + WS_BW); float* STAT = (float*)(ws + WS_STAT);
    bf16* W1T = (bf16*)(ws + WS_W1); bf16* W2T = (bf16*)(ws + WS_W2); bf16* WQKVT = (bf16*)(ws + WS_WQKV); bf16* WOT = (bf16*)(ws + WS_WO);
    _Float16* Z16 = GEMM_F16 ? (_Float16*)(ws + WS_ZB) : (_Float16*)(ws + WS_Z16);
    bf16* ZB = (bf16*)(ws + WS_ZB); bf16* QB = (bf16*)(ws + WS_QKV); bf16* KB = QB + (size_t)M * D; bf16* VB = KB + (size_t)M * D; bf16* HB = QB;
    for (int u = threadIdx.x; u < (STASH_OFF - MISC_OFF) / 4; u += NWAVES * 64) ((LAS unsigned*)(lds + MISC_OFF))[u] = 0u;
    __syncthreads();
    XcdBarrier bar = xcd_barrier_post(ctl + CW_BAR, MISC + 8);

    {
        PROBE_T0(3)
        const int tid = threadIdx.x, lane = tid & 63;
        LAS float* scr = (LAS float*)(lds + wave * 16384);
        const int gw = bx * NWAVES + wave, NGW = G * NWAVES;
        constexpr int I_F = 16 * 88, N_FFN = 8 * 3 * I_F, I_QKV = 16 * 96, I_O = 16 * 32, N_MIX = 4 * (I_QKV + I_O);
        for (int it = gw; it < N_FFN + N_MIX; it += NGW) {
            if (it < N_FFN) { const int mi = it / I_F, r = it % I_F, f = mi / 3, which = mi % 3;
                if (which < 2) { const int kb = r / 88, nb = r % 88, n0 = 32 * nb, s = 3 * (f >> 1) + 2 * (f & 1);
                    const float* W = args.in[6 + which] + (size_t)f * D * FF;
                    const int dst = (n0 >> 7) * 256 + (n0 & 127) + which * 128;
                    transpose_item(W, FF, W1T + (size_t)f * 2 * FF * D, D, 64 * kb, n0, dst, s > 0 ? ln_g + (s - 1) * D : nullptr, s > 0 ? ln_b + (s - 1) * D : nullptr, CS + f * 2 * FF, BW + f * 2 * FF, scr, lane, GEMM_F16);
                } else { const int kb = r / 32, nb = r % 32;
                    transpose_item(args.in[8] + (size_t)f * FF * D, D, W2T + (size_t)f * D * FF, FF, 64 * kb, 32 * nb, 32 * nb, nullptr, nullptr, nullptr, nullptr, scr, lane, false); }
            } else { const int it2 = it - N_FFN, li = it2 / (I_QKV + I_O), r = it2 % (I_QKV + I_O), j = li >> 1, s = 3 * li + 1;
                if (r < I_QKV) { const int kb = r / 96, nb = r % 96;
                    const float* W = args.in[(li & 1) ? 4 : 1] + (size_t)j * D * 3 * D;
                    transpose_item(W, 3 * D, WQKVT + (size_t)li * 3 * D * D, D, 64 * kb, 32 * nb, 32 * nb, ln_g + (s - 1) * D, ln_b + (s - 1) * D, CS + CSV_QKV + li * 3 * D, BW + CSV_QKV + li * 3 * D, scr, lane, GEMM_F16);
                } else { const int r2 = r - I_QKV, kb = r2 / 32, nb = r2 % 32;
                    const float* W = args.in[(li & 1) ? 5 : 2] + (size_t)j * D * D;
                    transpose_item(W, D, WOT + (size_t)li * D * D, D, 64 * kb, 32 * nb, 32 * nb, nullptr, nullptr, nullptr, nullptr, scr, lane, false); }
            }
        }
        for (int r = bx * (NWAVES * 64) + tid; r < M; r += G * NWAVES * 64) { IDSTAT[2 * r] = 0.0f; IDSTAT[2 * r + 1] = 1024.0f * (1.0f - 1e-5f); }
        const size_t nch = (size_t)M * D / 8, nthr = (size_t)G * NWAVES * 64;
        size_t c = (size_t)bx * (NWAVES * 64) + tid;
        for (; c + 3 * nthr < nch; c += 4 * nthr) {
            f32x4 a[4], b[4];
#pragma unroll
            for (int j = 0; j < 4; ++j) { a[j] = *(const f32x4*)(x_in + (c + j * nthr) * 8); b[j] = *(const f32x4*)(x_in + (c + j * nthr) * 8 + 4); }
#pragma unroll
            for (int j = 0; j < 4; ++j) { v4u o; o.x = pk2h(a[j][0], a[j][1]); o.y = pk2h(a[j][2], a[j][3]); o.z = pk2h(b[j][0], b[j][1]); o.w = pk2h(b[j][2], b[j][3]); *(v4u*)(ZB + (c + j * nthr) * 8) = o; } }
        for (; c < nch; c += nthr) { const f32x4 a = *(const f32x4*)(x_in + c * 8), b = *(const f32x4*)(x_in + c * 8 + 4);
            v4u o; o.x = pk2h(a[0], a[1]); o.y = pk2h(a[2], a[3]); o.z = pk2h(b[0], b[1]); o.w = pk2h(b[2], b[3]); *(v4u*)(ZB + c * 8) = o; }
        PROBE_T1(3)
    }
    __syncthreads();
    cg::this_grid().sync();

#define GRID_BAR() do { PROBE_T0(4) xcd_barrier(bar); PROBE_T1(4) } while (0)
#define GRID_BAR_C(cls) do { PROBE_T0(cls) xcd_barrier(bar); PROBE_T1(cls) } while (0)
#pragma unroll 1
    for (int li_ = 0; li_ < DEPTH; ++li_) {
#pragma unroll 1
        for (int sub_ = 0; sub_ < 3; ++sub_) {
            int li = li_, sub = sub_; asm volatile("" : "+s"(li), "+s"(sub)); unsigned zv_; asm volatile("v_mov_b32 %0, 0" : "=v"(zv_)); int tidv = wave * 64 + (int)__builtin_amdgcn_mbcnt_hi(~0u, __builtin_amdgcn_mbcnt_lo(~0u, zv_)); asm volatile("" : "+v"(tidv));
            const int s = 3 * li + sub;
            const float* stat_in = s > 0 ? STAT + (size_t)(s - 1) * M * 2 : IDSTAT;
            float* stat_out = STAT + (size_t)s * M * 2;
            const float* gin = ln_g + (s > 0 ? s - 1 : 0) * D; const float* bin = ln_b + (s > 0 ? s - 1 : 0) * D;
            { LAS float* gbw = (LAS float*)(lds + GB_OFF); for (int c = tidv; c < D; c += NWAVES * 64) { gbw[c] = s > 0 ? gin[c] : 1.0f; gbw[D + c] = s > 0 ? bin[c] : 0.0f; } }
            __syncthreads();
            if (sub != 1) {
                const int f = 2 * li + (sub >> 1);
                { PROBE_T0(1) pg8::Gemm g{ZB, W1T + (size_t)f * 2 * FF * D, M, 2 * FF, D}; pg8::StaticOrder S; S.init(M, 2 * FF, G, bx);
                  pg8::EpiSwiglu E{HB, stat_in, CS + f * 2 * FF, BW + f * 2 * FF, (LAS float*)(lds + STASH_OFF)};
                  asm volatile("" : "+v"(tidv)); { const pg8::ListOrder LO = pg8::make_list(S, (LAS int*)(lds + ULIST_OFF), tidv); pg8::gemm_phase<pg8::EpiSwiglu, pg8::ListOrder, true, true, GEMM_F16>(lds, tidv, g, LO, E); } PROBE_T1(1) }
                GRID_BAR_C(11);
                { PROBE_T0(1) pg8::Gemm g{HB, W2T + (size_t)f * D * FF, M, D, FF}; pg8::StaticOrder S; S.init(M, D, G, bx, 1);
                  pg8::EpiResid E{Z16, stat_in, (const LAS float*)(lds + GB_OFF), stat_out, 0.5f};
                  asm volatile("" : "+v"(tidv)); { const pg8::ListOrder LO = pg8::make_list(S, (LAS int*)(lds + ULIST_OFF), tidv); pg8::gemm_phase<pg8::EpiResid, pg8::ListOrder, true, true>(lds, tidv, g, LO, E); } PROBE_T1(1) }
                GRID_BAR_C(12);
            } else {
                { PROBE_T0(1) pg8::Gemm g{ZB, WQKVT + (size_t)li * 3 * D * D, M, 3 * D, D}; pg8::StaticOrder S; S.init(M, 3 * D, G, bx);
                  pg8::EpiQKV E{QB, (size_t)M * D, stat_in, CS + CSV_QKV + li * 3 * D, BW + CSV_QKV + li * 3 * D, 0.125f * 1.4426950408889634f, (LAS float*)(lds + STASH_OFF)};
                  asm volatile("" : "+v"(tidv)); { const pg8::ListOrder LO = pg8::make_list(S, (LAS int*)(lds + ULIST_OFF), tidv); pg8::gemm_phase<pg8::EpiQKV, pg8::ListOrder, true, true, GEMM_F16>(lds, tidv, g, LO, E); } PROBE_T1(1) }
                GRID_BAR_C(13);
                asm volatile("" : "+v"(tidv));
                { PROBE_T0(2)
                for (int vb = bx; vb < 256; vb += G) { const int grp = vb >> 1, e = vb & 1, b = grp >> 3, hp = grp & 7;
                    att::bf16x8 qn[4]; att::Stage Sn; att::u32x4 k1n[2];
                    if ((li & 1) == 0) { att::chunk_prefetch(b, hp, e ^ 1, QB, KB, VB, qn, Sn, k1n, tidv);
                        for (int i = 0; i < 8; ++i) { asm volatile("" : "+v"(tidv)); att::chunk_attn_unit(b, hp, i == 0 ? (e ^ 1) : 2 * i + e, i < 7 ? 2 * (i + 1) + e : -1, qn, Sn, k1n, QB, KB, VB, QB, rel, lds, tidv); } }
                    else { att::stick_prefetch(b, hp, e, QB, KB, VB, qn, Sn, tidv);
                        for (int i = 0; i < 8; ++i) { const int k = 2 * (i >> 1) + e, qb = (i & 1) ? 15 - k : k, i1 = i + 1, k1 = 2 * (i1 >> 1) + e, qb1 = i1 < 8 ? ((i1 & 1) ? 15 - k1 : k1) : -1;
                            asm volatile("" : "+v"(tidv)); att::stick_attn_unit(b, hp, qb, qb1, qn, Sn, QB, KB, VB, QB, lds, tidv); } } }
                PROBE_T1(2) }
                GRID_BAR_C(14);
                { PROBE_T0(1) pg8::Gemm g{QB, WOT + (size_t)li * D * D, M, D, D}; pg8::StaticOrder S; S.init(M, D, G, bx);
                  pg8::EpiResid E{Z16, stat_in, (const LAS float*)(lds + GB_OFF), stat_out, 1.0f};
                  asm volatile("" : "+v"(tidv)); { const pg8::ListOrder LO = pg8::make_list(S, (LAS int*)(lds + ULIST_OFF), tidv); pg8::gemm_phase<pg8::EpiResid, pg8::ListOrder, true, true>(lds, tidv, g, LO, E); } PROBE_T1(1) }
                GRID_BAR_C(15);
            }
        }
    }
    {
        PROBE_T0(5)
        unsigned zv2_; asm volatile("v_mov_b32 %0, 0" : "=v"(zv2_)); const int lane = (int)__builtin_amdgcn_mbcnt_hi(~0u, __builtin_amdgcn_mbcnt_lo(~0u, zv2_));
        const int gw = bx * NWAVES + wave, NGW = G * NWAVES; const float* gl = ln_g + 11 * D; const float* bl = ln_b + 11 * D;
        f32x4 ggv[4], bbv[4];
#pragma unroll
        for (int j = 0; j < 4; ++j) { const int c4 = 2 * lane + (j & 1) + 128 * (j >> 1); ggv[j] = *((const f32x4*)gl + c4); bbv[j] = *((const f32x4*)bl + c4); }
        auto ln_rows = [&](const int m0, const int nr) __attribute__((always_inline)) {
            pg8::f16x8 h[2][2];
#pragma unroll
            for (int r = 0; r < 2; ++r) if (r < nr) { const pg8::f16x8* zr16 = (const pg8::f16x8*)(Z16 + (size_t)(m0 + r * NGW) * D) + lane;
                h[r][0] = zr16[0]; h[r][1] = zr16[64]; }
#pragma unroll
            for (int r = 0; r < 2; ++r) if (r < nr) { const int m = m0 + r * NGW; f32x4 v[4]; float s = 0.f;
#pragma unroll
                for (int jj = 0; jj < 2; ++jj) { v[2 * jj] = (f32x4){(float)h[r][jj][0], (float)h[r][jj][1], (float)h[r][jj][2], (float)h[r][jj][3]}; v[2 * jj + 1] = (f32x4){(float)h[r][jj][4], (float)h[r][jj][5], (float)h[r][jj][6], (float)h[r][jj][7]}; }
#pragma unroll
                for (int j = 0; j < 4; ++j) s += (v[j][0] + v[j][1]) + (v[j][2] + v[j][3]);
                const float mean = wave_sum(s) * (1.f / D); float s2 = 0.f;
#pragma unroll
                for (int j = 0; j < 4; ++j) { v[j] = v[j] - mean; s2 += (v[j][0] * v[j][0] + v[j][1] * v[j][1]) + (v[j][2] * v[j][2] + v[j][3] * v[j][3]); }
                const float rstd = 1.f / sqrtf(wave_sum(s2) * (1.f / D) + 1e-5f);
#pragma unroll
                for (int j = 0; j < 4; ++j) { const int c4 = 2 * lane + (j & 1) + 128 * (j >> 1);
                    *((f32x4*)(zout + (size_t)m * D) + c4) = v[j] * rstd * ggv[j] + bbv[j]; } }
        };
        int m = gw;
        for (; m + NGW < M; m += 2 * NGW) ln_rows(m, 2);
        if (m < M) ln_rows(m, 1);
        PROBE_T1(5)
    }
}

extern "C" void kernel_launch(void* const* d_in, const int* in_sizes, int n_in, void* d_out, int out_size, void* d_ws, size_t ws_size, hipStream_t stream) {
    static int grid = 0;
    if (grid == 0) {
        if (n_in != 11 || ws_size < WS_END) { fprintf(stderr, "kernel_launch: unexpected inputs (n_in %d, ws %zu)\n", n_in, ws_size); grid = -1; return; }
        int dev = 0, cus = 0, per_cu = 0;
        (void)hipGetDevice(&dev); (void)hipDeviceGetAttribute(&cus, hipDeviceAttributeMultiprocessorCount, dev);
        (void)hipFuncSetAttribute((const void*)fwd_megakernel, hipFuncAttributeMaxDynamicSharedMemorySize, LDS_BYTES);
        if (hipOccupancyMaxActiveBlocksPerMultiprocessor(&per_cu, (const void*)fwd_megakernel, NWAVES * 64, LDS_BYTES) != hipSuccess || per_cu < 1) { fprintf(stderr, "kernel_launch: occupancy query says %d\n", per_cu); per_cu = 1; }
        (void)hipGetLastError();
        grid = cus;
        if (grid > 256) grid = 256;
    }
    if (grid < 0) return;
    (void)hipMemsetAsync((char*)d_ws + WS_CTL, 0, CTL_ZERO_BYTES, stream);
    Args a{};
    for (int i = 0; i < 11; ++i) a.in[i] = (const float*)d_in[i];
    a.out = (float*)d_out; a.ws = (unsigned char*)d_ws;
    void* kargs[] = {&a};
    hipError_t e = hipLaunchCooperativeKernel((const void*)fwd_megakernel, dim3(grid), dim3(NWAVES * 64), kargs, LDS_BYTES, stream);
    if (e != hipSuccess) fprintf(stderr, "cooperative launch failed: %s (grid %d)\n", hipGetErrorString(e), grid);
}
```

```cpp
#include <hip/hip_runtime.h>
#include <hip/hip_cooperative_groups.h>
#include <cstdio>
#include <cstdint>
namespace cg = cooperative_groups;
namespace pg8 {
#define PG8_LAS __attribute__((address_space(3)))
typedef unsigned short bf16_t;
typedef short bf16x8 __attribute__((ext_vector_type(8)));
typedef float f32x4 __attribute__((ext_vector_type(4)));
typedef unsigned u32x4 __attribute__((ext_vector_type(4)));
constexpr int BM = 256, BK = 64, HALF = 128, HTB = HALF * BK * 2  , STAGE_BYTES = 8 * HTB, NXCD = 8, WGM = 8;

__host__ __device__ __forceinline__ int lds_byte(int r, int c) { const int st = (r >> 4) * 2 + (c >> 5), rr = r & 15, cc = c & 31, ob = rr * 64 + cc * 2; return st * 1024 + (ob ^ (((ob >> 9) & 1) << 5)); }
__host__ __device__ __forceinline__ void stage_rc(int b, int& R, int& C) { const int st = b / 1024, sb = b % 1024, swz = sb ^ (((sb >> 9) & 1) << 5); R = (st >> 1) * 16 + swz / 64; C = (st & 1) * 32 + (swz % 64) / 2; }
__host__ __device__ __forceinline__ int perm32(int rho) { const int n = rho >> 4, i = rho & 15; return 8 * (i >> 2) + 4 * n + (i & 3); }

struct Unit { int pm, pn; };
struct Gemm { const bf16_t* A; const bf16_t* Bt; int M, N, K; };

struct StaticOrder {
    int nM, nN, nwg, G, c, rev;
    __host__ __device__ void init(int M, int N, int G_, int c_, int rev_ = 0) { nM = M / BM; nN = N / BM; nwg = nM * nN; G = G_; c = c_; rev = (rev_ && nwg % G_ == 0) ? nwg / G_ : 0; }
    __host__ __device__ bool next(int i, Unit& u) const {
        const long L = (long)(rev ? rev - 1 - i : i) * G + c; if (L >= nwg || L < 0) return false;
        int wgid = (int)L; { const int q = nwg / NXCD, r = nwg % NXCD, xcd = wgid % NXCD, off = wgid / NXCD; wgid = (xcd < r ? xcd * (q + 1) : r * (q + 1) + (xcd - r) * q) + off; }
        const int nig = WGM * nN, gid = wgid / nig, fm = gid * WGM, gsz = (nM - fm) < WGM ? (nM - fm) : WGM;
        u.pm = fm + ((wgid % nig) % gsz); u.pn = (wgid % nig) / gsz; return true;
    }
    __device__ __forceinline__ void a_ready(const Unit&) const {}
    __device__ __forceinline__ void done(const Unit&) const {}
};

__device__ __forceinline__ unsigned cvt_pk_bf16(float lo, float hi) { unsigned r; asm volatile("v_cvt_pk_bf16_f32 %0, %1, %2" : "=v"(r) : "v"(lo), "v"(hi)); return r; }
typedef float f32x2 __attribute__((ext_vector_type(2)));
typedef _Float16 f16x8 __attribute__((ext_vector_type(8)));
template <bool F16> __device__ __forceinline__ f32x4 mma16(bf16x8 a, bf16x8 b, f32x4 c) {
    if constexpr (F16) return __builtin_amdgcn_mfma_f32_16x16x32_f16(__builtin_bit_cast(f16x8, a), __builtin_bit_cast(f16x8, b), c, 0, 0, 0);
    else return __builtin_amdgcn_mfma_f32_16x16x32_bf16(a, b, c, 0, 0, 0);
}
__device__ __forceinline__ float ld_agent_f32(const float* p) { return __hip_atomic_load(p, __ATOMIC_RELAXED, __HIP_MEMORY_SCOPE_AGENT); }
typedef unsigned u32x2 __attribute__((ext_vector_type(2)));
__device__ __forceinline__ void row_stats8(const float* st, int row0, float (&mu)[2][4], float (&rs)[2][4]) {
#pragma unroll
    for (int ai = 0; ai < 2; ++ai)
#pragma unroll
        for (int m = 0; m < 4; ++m) { if (st) { const int row = row0 + ai * HALF + m * 16; const f32x2 sq = *(const f32x2*)(st + 2 * row);
            const float mm = sq[0] * (1.0f / 1024.0f), var = fmaxf(sq[1] * (1.0f / 1024.0f) - mm * mm, 0.f); mu[ai][m] = mm; rs[ai][m] = __builtin_amdgcn_rsqf(var + 1e-5f); } else { mu[ai][m] = 0.f; rs[ai][m] = 1.f; } }
}
__device__ __forceinline__ void stash_unit(const Unit& u, int wid, int lane, const float* cs, const float* bw, const float* stat, PG8_LAS float* st) {
    const float* src = (wid < 4 ? cs : bw) + u.pn * BM + (wid & 3) * 64 + lane;
    __builtin_amdgcn_global_load_lds((const unsigned*)src, (PG8_LAS unsigned*)(st + wid * 64), 4, 0, 0);
    __builtin_amdgcn_global_load_lds((const unsigned*)(stat + 2 * (size_t)(u.pm * BM) + wid * 64 + lane), (PG8_LAS unsigned*)(st + 512 + wid * 64), 4, 0, 0);
}
__device__ __forceinline__ void row_stats8_lds(const PG8_LAS float* st, int rl0, float (&mu)[2][4], float (&rs)[2][4]) {
#pragma unroll
    for (int ai = 0; ai < 2; ++ai)
#pragma unroll
        for (int m = 0; m < 4; ++m) { const f32x2 sq = *(const PG8_LAS f32x2*)(st + 512 + 2 * (rl0 + ai * HALF + m * 16));
            const float mm = sq[0] * (1.0f / 1024.0f), var = fmaxf(sq[1] * (1.0f / 1024.0f) - mm * mm, 0.f); mu[ai][m] = mm; rs[ai][m] = __builtin_amdgcn_rsqf(var + 1e-5f); }
}
struct EpiSwiglu {
    static constexpr bool PERM = true, AFTER_DRAIN = false, STASH = true;
    bf16_t* H; const float* stat; const float* cs; const float* bw; PG8_LAS float* st;
    __device__ __forceinline__ void stash(const Unit& u, int wid, int lane) const { stash_unit(u, wid, lane, cs, bw, stat, st); }
    __device__ __forceinline__ void operator()(const f32x4 (&acc)[2][2][4][2], const Unit& u, int wr, int wc, int fr, int fq) const {
        const int row0 = u.pm * BM + wr * 64 + fr; const int cc = u.pn * BM + wc * 32 + 8 * fq; const int hc = u.pn * HALF + wc * 32 + 8 * fq;
        float mu[2][4], rs[2][4]; row_stats8_lds(st, wr * 64 + fr, mu, rs);
        const int lc = wc * 32 + 8 * fq;
        f32x4 csg[2], csu[2], bwg[2], bwu[2];
#pragma unroll
        for (int n = 0; n < 2; ++n) { csg[n] = *(const PG8_LAS f32x4*)(st + lc + 4 * n); csu[n] = *(const PG8_LAS f32x4*)(st + lc + HALF + 4 * n); bwg[n] = *(const PG8_LAS f32x4*)(st + 256 + lc + 4 * n); bwu[n] = *(const PG8_LAS f32x4*)(st + 256 + lc + HALF + 4 * n); }
#pragma unroll
        for (int ai = 0; ai < 2; ++ai)
#pragma unroll
            for (int m = 0; m < 4; ++m) { const int row = row0 + ai * HALF + m * 16; f32x4 hv[2];
#pragma unroll
                for (int n = 0; n < 2; ++n) { const f32x4 g = (acc[ai][0][m][n] - csg[n] * mu[ai][m]) * rs[ai][m] + bwg[n], up = (acc[ai][1][m][n] - csu[n] * mu[ai][m]) * rs[ai][m] + bwu[n];
                    const f32x4 t = g * -1.4426950408889634f; f32x4 e = (f32x4){__builtin_amdgcn_exp2f(t[0]), __builtin_amdgcn_exp2f(t[1]), __builtin_amdgcn_exp2f(t[2]), __builtin_amdgcn_exp2f(t[3])};
                    e = e + 1.0f; const f32x4 r = (f32x4){__builtin_amdgcn_rcpf(e[0]), __builtin_amdgcn_rcpf(e[1]), __builtin_amdgcn_rcpf(e[2]), __builtin_amdgcn_rcpf(e[3])};
                    hv[n] = (g * up) * r; }
                u32x4 w; w.x = cvt_pk_bf16(hv[0][0], hv[0][1]); w.y = cvt_pk_bf16(hv[0][2], hv[0][3]); w.z = cvt_pk_bf16(hv[1][0], hv[1][1]); w.w = cvt_pk_bf16(hv[1][2], hv[1][3]);
                *(u32x4*)(H + (size_t)row * 2816 + hc) = w; }
    }
};
struct EpiQKV {
    static constexpr bool PERM = true, AFTER_DRAIN = false, STASH = true;
    bf16_t* Q; size_t tstride; const float* stat; const float* cs; const float* bw; float qscale; PG8_LAS float* st;
    __device__ __forceinline__ void stash(const Unit& u, int wid, int lane) const { stash_unit(u, wid, lane, cs, bw, stat, st); }
    __device__ __forceinline__ void operator()(const f32x4 (&acc)[2][2][4][2], const Unit& u, int wr, int wc, int fr, int fq) const {
        const int row0 = u.pm * BM + wr * 64 + fr; const int cc = u.pn * BM + wc * 32 + 8 * fq;
        const int t = (u.pn * BM) >> 10; bf16_t* base = Q + (size_t)t * tstride; const int col0 = ((u.pn * BM) & 1023) + wc * 32 + 8 * fq; const float sc = (t == 0) ? qscale : 1.0f;
        float mu[2][4], rs[2][4]; row_stats8_lds(st, wr * 64 + fr, mu, rs);
        const int lc = wc * 32 + 8 * fq;
#pragma unroll
        for (int bj = 0; bj < 2; ++bj) { const f32x4 cs0 = *(const PG8_LAS f32x4*)(st + lc + bj * HALF), cs1 = *(const PG8_LAS f32x4*)(st + lc + bj * HALF + 4), bw0 = *(const PG8_LAS f32x4*)(st + 256 + lc + bj * HALF), bw1 = *(const PG8_LAS f32x4*)(st + 256 + lc + bj * HALF + 4);
#pragma unroll
            for (int ai = 0; ai < 2; ++ai)
#pragma unroll
                for (int m = 0; m < 4; ++m) { const int row = row0 + ai * HALF + m * 16;
                    const f32x4 v0 = ((acc[ai][bj][m][0] - cs0 * mu[ai][m]) * rs[ai][m] + bw0) * sc, v1 = ((acc[ai][bj][m][1] - cs1 * mu[ai][m]) * rs[ai][m] + bw1) * sc;
                    u32x4 w; w.x = cvt_pk_bf16(v0[0], v0[1]); w.y = cvt_pk_bf16(v0[2], v0[3]); w.z = cvt_pk_bf16(v1[0], v1[1]); w.w = cvt_pk_bf16(v1[2], v1[3]);
                    *(u32x4*)(base + (size_t)row * 1024 + col0 + bj * HALF) = w; } }
    }
};
struct EpiResid {
    static constexpr bool PERM = true, AFTER_DRAIN = false, STASH = false;
    _Float16* z; const float* stat_in; const PG8_LAS float* gb; float* stat_out; float coef;
    __device__ __forceinline__ void operator()(const f32x4 (&acc)[2][2][4][2], const Unit& u, int wr, int wc, int fr, int fq) const {
        constexpr float ALPHA = 1.681792830507429f;
        const int row0 = u.pm * BM + wr * 64 + fr; const int col0 = u.pn * BM + wc * 32 + 8 * fq;
#pragma unroll
        for (int ai = 0; ai < 2; ++ai) {
            f32x2 sq[4]; f16x8 hh[4][2];
#pragma unroll
            for (int m = 0; m < 4; ++m) { sq[m] = *(const f32x2*)(stat_in + 2 * (row0 + ai * HALF + m * 16));
#pragma unroll
                for (int bj = 0; bj < 2; ++bj) hh[m][bj] = *(const f16x8*)(z + (unsigned)(row0 + ai * HALF + m * 16) * 1024u + (unsigned)col0 + bj * HALF); }
            float tprev = 0.f;
#pragma unroll
            for (int m = 0; m < 4; ++m) { const int row = row0 + ai * HALF + m * 16; const unsigned off = (unsigned)row * 1024u + (unsigned)col0;
                const f16x8 (&h)[2] = hh[m];
                const float mu = sq[m][0] * (1.0f / 1024.0f), var = fmaxf(sq[m][1] * (1.0f / 1024.0f) - mu * mu, 0.f), rs = __builtin_amdgcn_rsqf(var + 1e-5f);
                float s = 0.f, q = 0.f;
#pragma unroll
                for (int bj = 0; bj < 2; ++bj) { f32x4 zn[2];
#pragma unroll
                    for (int n = 0; n < 2; ++n) { const f32x4 zr = (f32x4){(float)h[bj][4 * n], (float)h[bj][4 * n + 1], (float)h[bj][4 * n + 2], (float)h[bj][4 * n + 3]};
                        const f32x4 gv = *(const PG8_LAS f32x4*)(gb + col0 + bj * HALF + 4 * n), bv = *(const PG8_LAS f32x4*)(gb + 1024 + col0 + bj * HALF + 4 * n);
                        const f32x4 xn = (zr - mu) * rs * gv + bv;
                        zn[n] = xn * ALPHA + acc[ai][bj][m][n] * coef;
                        s += (zn[n][0] + zn[n][1]) + (zn[n][2] + zn[n][3]); q += (zn[n][0] * zn[n][0] + zn[n][1] * zn[n][1]) + (zn[n][2] * zn[n][2] + zn[n][3] * zn[n][3]); }
                    const f16x8 w = (f16x8){(_Float16)zn[0][0], (_Float16)zn[0][1], (_Float16)zn[0][2], (_Float16)zn[0][3], (_Float16)zn[1][0], (_Float16)zn[1][1], (_Float16)zn[1][2], (_Float16)zn[1][3]};
                    *(f16x8*)(z + off + bj * HALF) = w; }
                const bool odd = (fq & 1) != 0; float t = odd ? q : s; const float u = odd ? s : q;
                t += __shfl_xor(u, 16); t += __shfl_xor(t, 32);
                if (m & 1) { const int arow = row0 + ai * HALF + (m - 1 + (fq >> 1)) * 16; unsafeAtomicAdd(stat_out + 2 * arow + (fq & 1), (fq >> 1) ? t : tprev); }
                tprev = t; }
            asm volatile("" ::: "memory"); }
    }
};

template <class Epi, class Sched, bool ALIGN_EPI = false, bool SP2 = false, bool F16 = false>
__device__ __forceinline__ void gemm_phase(PG8_LAS unsigned char* lds, const int tid, const Gemm g, const Sched& S, const Epi& E) {
    const int  wid = __builtin_amdgcn_readfirstlane(tid >> 6), lane = tid & 63, wr = wid >> 2, wc = wid & 3, fr = lane & 15, fq = lane >> 4;
    const int K = g.K, nt = K / BK;
    unsigned voffA[2], voffB[2];
#pragma unroll
    for (int i = 0; i < 2; ++i) { int R, C; stage_rc(tid * 16 + i * 8192, R, C); const int Rb = Epi::PERM ? ((R & ~31) + perm32(R & 31)) : R;
        voffA[i] = (unsigned)(R * K + C) * 2u; voffB[i] = (unsigned)(Rb * K + C) * 2u; }
    const size_t kstep = (size_t)(BK * 2);
    const size_t hstep = (size_t)HALF * K * 2;
    const size_t tstep = 2 * hstep;
    const unsigned ldsw = (unsigned)wid * 1024u;
    const int aoff = lds_byte(wr * 64 + fr, fq * 8), boff = lds_byte(wc * 32 + fr, fq * 8);
#define PG8_SA(b, h) (((b) * 2 + (h)) * HTB)
#define PG8_SB(b, h) ((4 + (b) * 2 + (h)) * HTB)
#define PG8_STAGE(bufoff, gbase, voff) do { _Pragma("unroll") for (int _i = 0; _i < 2; ++_i) \
        __builtin_amdgcn_global_load_lds((const unsigned*)((const char*)(gbase) + (voff)[_i]), (PG8_LAS unsigned*)(lds + (bufoff) + ldsw + _i * 8192), 16, 0, 0); } while (0)
#define PG8_LDA(dst, b, h) do { _Pragma("unroll") for (int m = 0; m < 4; ++m) _Pragma("unroll") for (int k = 0; k < 2; ++k) dst[m][k] = *(const PG8_LAS bf16x8*)(lds + PG8_SA(b, h) + aoff + m * 2048 + k * 1024); } while (0)
#define PG8_LDB(dst, b, h) do { _Pragma("unroll") for (int n = 0; n < 2; ++n) _Pragma("unroll") for (int k = 0; k < 2; ++k) dst[n][k] = *(const PG8_LAS bf16x8*)(lds + PG8_SB(b, h) + boff + n * 2048 + k * 1024); } while (0)
#define PG8_MMA(ai, bj, At, Bt) do { __builtin_amdgcn_s_setprio(1); _Pragma("unroll") for (int m = 0; m < 4; ++m) _Pragma("unroll") for (int n = 0; n < 2; ++n) _Pragma("unroll") for (int k = 0; k < 2; ++k) \
        acc[ai][bj][m][n] = mma16<F16>(Bt[n][k], At[m][k], acc[ai][bj][m][n]); __builtin_amdgcn_s_setprio(0); } while (0)
#define PG8_WAIT_V(n) asm volatile("s_waitcnt vmcnt(" #n ")" ::: "memory")
#define PG8_WAIT_L(n) asm volatile("s_waitcnt lgkmcnt(" #n ")" ::: "memory")
#define PG8_BAR __builtin_amdgcn_s_barrier()
#define PG8_SCHED __builtin_amdgcn_sched_barrier(0)
    Unit cur, nxt; int ui = 0;
    if (!S.next(0, cur)) return;
    f32x4 acc[2][2][4][2];
#pragma unroll
    for (int a = 0; a < 2; ++a)
#pragma unroll
        for (int b = 0; b < 2; ++b)
#pragma unroll
            for (int m = 0; m < 4; ++m)
#pragma unroll
                for (int n = 0; n < 2; ++n) acc[a][b][m][n] = (f32x4){0.f, 0.f, 0.f, 0.f};
    bf16x8 At[4][2], B0[2][2], B1[2][2];
    const char* cA = (const char*)g.A + (size_t)cur.pm * tstep; const char* cB = (const char*)g.Bt + (size_t)cur.pn * tstep;
    S.a_ready(cur);
    if constexpr (SP2) {
        PG8_STAGE(PG8_SB(0, 0), cB, voffB); PG8_STAGE(PG8_SB(0, 1), cB + hstep, voffB); PG8_STAGE(PG8_SA(0, 0), cA, voffA); PG8_STAGE(PG8_SA(0, 1), cA + hstep, voffA);
        if (wr == 1) PG8_BAR;
        PG8_WAIT_V(2); PG8_BAR;
        PG8_STAGE(PG8_SB(1, 0), cB + kstep, voffB); PG8_STAGE(PG8_SA(1, 0), cA + kstep, voffA); PG8_STAGE(PG8_SB(1, 1), cB + hstep + kstep, voffB);
        PG8_WAIT_V(6); PG8_BAR;
    } else {
        PG8_STAGE(PG8_SB(0, 0), cB, voffB); PG8_STAGE(PG8_SA(0, 0), cA, voffA); PG8_STAGE(PG8_SB(0, 1), cB + hstep, voffB); PG8_STAGE(PG8_SA(0, 1), cA + hstep, voffA);
        if (wr == 1) PG8_BAR;
        PG8_WAIT_V(4); PG8_BAR;
        PG8_STAGE(PG8_SB(1, 0), cB + kstep, voffB); PG8_STAGE(PG8_SA(1, 0), cA + kstep, voffA); PG8_STAGE(PG8_SB(1, 1), cB + hstep + kstep, voffB);
        PG8_WAIT_V(6); PG8_BAR;
    }
    for (;;) {
        const bool has_next = S.next(ui + 1, nxt);
        const char* nA = has_next ? (const char*)g.A + (size_t)nxt.pm * tstep : cA; const char* nB = has_next ? (const char*)g.Bt + (size_t)nxt.pn * tstep : cB;
        for (int t = 0; t < nt; t += 2) {
            const bool last = (t == nt - 2);
            const char* a1 = cA + (size_t)(t + 1) * kstep;
            const char* a2 = last ? nA : cA + (size_t)(t + 2) * kstep; const char* b2 = last ? nB : cB + (size_t)(t + 2) * kstep;
            const char* a3 = a2 + kstep; const char* b3 = b2 + kstep;
            if (last && has_next) S.a_ready(nxt);
            if constexpr (Epi::STASH) { if (last) E.stash(cur, wid, lane); }
            if constexpr (SP2) {
            PG8_LDB(B0, 0, 0); PG8_LDB(B1, 0, 1); PG8_SCHED; PG8_LDA(At, 0, 0); PG8_STAGE(PG8_SA(1, 1), a1 + hstep, voffA);
            PG8_WAIT_V(8); PG8_WAIT_L(0); PG8_BAR; PG8_MMA(0, 0, At, B0); PG8_MMA(0, 1, At, B1); PG8_BAR; PG8_SCHED;
            PG8_LDA(At, 0, 1); PG8_STAGE(PG8_SB(0, 0), b2, voffB); PG8_STAGE(PG8_SB(0, 1), b2 + hstep, voffB); PG8_STAGE(PG8_SA(0, 0), a2, voffA);
            PG8_WAIT_V(8); PG8_WAIT_L(0); PG8_BAR; PG8_MMA(1, 0, At, B0); PG8_MMA(1, 1, At, B1); PG8_BAR; PG8_SCHED;
            PG8_LDB(B0, 1, 0); PG8_LDB(B1, 1, 1); PG8_SCHED; PG8_LDA(At, 1, 0); PG8_STAGE(PG8_SA(0, 1), a2 + hstep, voffA);
            PG8_WAIT_V(8); PG8_WAIT_L(0); PG8_BAR; PG8_MMA(0, 0, At, B0); PG8_MMA(0, 1, At, B1); PG8_BAR; PG8_SCHED;
            PG8_LDA(At, 1, 1); PG8_STAGE(PG8_SB(1, 0), b3, voffB); PG8_STAGE(PG8_SB(1, 1), b3 + hstep, voffB); PG8_STAGE(PG8_SA(1, 0), a3, voffA);
            PG8_WAIT_V(8); PG8_WAIT_L(0); PG8_BAR; PG8_MMA(1, 0, At, B0); PG8_MMA(1, 1, At, B1); PG8_BAR; PG8_SCHED;
            } else {
            PG8_LDB(B0, 0, 0); PG8_SCHED; PG8_LDA(At, 0, 0); PG8_STAGE(PG8_SA(1, 1), a1 + hstep, voffA);
            PG8_WAIT_L(8); PG8_BAR; PG8_WAIT_L(0); PG8_MMA(0, 0, At, B0); PG8_BAR; PG8_SCHED;
            PG8_LDB(B1, 0, 1); PG8_STAGE(PG8_SB(0, 0), b2, voffB);
            PG8_BAR; PG8_WAIT_L(0); PG8_MMA(0, 1, At, B1); PG8_BAR;
            PG8_LDA(At, 0, 1); PG8_STAGE(PG8_SA(0, 0), a2, voffA);
            PG8_BAR; PG8_WAIT_L(0); PG8_MMA(1, 0, At, B0); PG8_BAR; PG8_SCHED;
            PG8_STAGE(PG8_SB(0, 1), b2 + hstep, voffB);
            PG8_WAIT_V(6); PG8_BAR; PG8_MMA(1, 1, At, B1); PG8_BAR;
            PG8_LDB(B0, 1, 0); PG8_SCHED; PG8_LDA(At, 1, 0); PG8_STAGE(PG8_SA(0, 1), a2 + hstep, voffA);
            PG8_WAIT_L(8); PG8_BAR; PG8_WAIT_L(0); PG8_MMA(0, 0, At, B0); PG8_BAR; PG8_SCHED;
            PG8_LDB(B1, 1, 1); PG8_STAGE(PG8_SB(1, 0), b3, voffB);
            PG8_BAR; PG8_WAIT_L(0); PG8_MMA(0, 1, At, B1); PG8_BAR;
            PG8_LDA(At, 1, 1); PG8_STAGE(PG8_SA(1, 0), a3, voffA);
            PG8_BAR; PG8_WAIT_L(0); PG8_MMA(1, 0, At, B0); PG8_BAR; PG8_SCHED;
            PG8_STAGE(PG8_SB(1, 1), b3 + hstep, voffB);
            PG8_WAIT_V(6); PG8_BAR; PG8_MMA(1, 1, At, B1); PG8_BAR;
            }
        }
        if constexpr (ALIGN_EPI) { if (wr == 0) PG8_BAR; }
        if constexpr (!Epi::AFTER_DRAIN) { E(acc, cur, wr, wc, fr, fq); S.done(cur); }
        if (!has_next) break;
#pragma unroll
        for (int a = 0; a < 2; ++a)
#pragma unroll
            for (int b = 0; b < 2; ++b)
#pragma unroll
                for (int m = 0; m < 4; ++m)
#pragma unroll
                    for (int n = 0; n < 2; ++n) acc[a][b][m][n] = (f32x4){0.f, 0.f, 0.f, 0.f};
        cur = nxt; cA = nA; cB = nB; ++ui;
        if constexpr (ALIGN_EPI) { if (wr == 1) PG8_BAR; }
    }
    PG8_WAIT_V(0);
    if constexpr (!ALIGN_EPI) { if (wr == 0) PG8_BAR; }
    PG8_BAR;
    if constexpr (Epi::AFTER_DRAIN) { E.fused(acc, cur, wr, wc, fr, fq, lds, wid, lane); S.done(cur); }
#undef PG8_SA
#undef PG8_SB
#undef PG8_STAGE
#undef PG8_LDA
#undef PG8_LDB
#undef PG8_MMA
#undef PG8_WAIT_V
#undef PG8_WAIT_L
#undef PG8_BAR
#undef PG8_SCHED
}
}
namespace att {
#define ALAS __attribute__((address_space(3)))
typedef unsigned short bf16_t;
typedef short bf16x8 __attribute__((ext_vector_type(8)));
typedef short s16x4 __attribute__((ext_vector_type(4)));
typedef float f32x16 __attribute__((ext_vector_type(16)));
typedef unsigned u32x4 __attribute__((ext_vector_type(4)));
constexpr int DM = 1024, SEQ = 2048;
constexpr int VHALF = 4096;
constexpr int L_KV = 0;
constexpr int L_WSF = 65536;
constexpr int L_TAB = 65536 + 2048;
constexpr int L_OST = 65536 + 8192;
constexpr int L_FLAG = L_OST + 32768;
constexpr float LOG2E = 1.4426950408889634f;
__device__ __forceinline__ int crow(int r, int hi) { return (r & 3) + 8 * (r >> 2) + 4 * hi; }
__device__ __forceinline__ unsigned cvtpk(float lo, float hi) { unsigned r; asm volatile("v_cvt_pk_bf16_f32 %0, %1, %2" : "=v"(r) : "v"(lo), "v"(hi)); return r; }
typedef short v4i16_t __attribute__((ext_vector_type(4)));
__device__ __forceinline__ s16x4 vtr(const ALAS unsigned char* p) { return __builtin_bit_cast(s16x4, __builtin_amdgcn_ds_read_tr16_b64_v4i16((ALAS v4i16_t*)p)); }

struct Stage { u32x4 k[2], v[2]; };
__device__ __forceinline__ void stage_load(Stage& s, const bf16_t* Kg, const bf16_t* Vg, long tok0, int hcol, int t256) {
#pragma unroll
    for (int i = 0; i < 2; ++i) { const int cid = t256 + 256 * i, row = cid >> 3, ch = cid & 7; const size_t o = (size_t)(tok0 + row) * DM + hcol + ch * 8;
        s.k[i] = *(const u32x4*)(Kg + o); s.v[i] = *(const u32x4*)(Vg + o); }
}
__device__ __forceinline__ void stage_store(const Stage& s, ALAS unsigned char* kbuf, ALAS unsigned char* vbuf, int t256) {
#pragma unroll
    for (int i = 0; i < 2; ++i) { const int cid = t256 + 256 * i, row = cid >> 3, ch = cid & 7;
        *(ALAS u32x4*)(kbuf + row * 128 + ((ch ^ ((row >> 1) & 7)) << 4)) = s.k[i];
        *(ALAS u32x4*)(vbuf + (ch >> 2) * VHALF + row * 64 + (ch & 3) * 16) = s.v[i]; }
}
__device__ __forceinline__ void qk_tile(f32x16& p0, f32x16& p1, const ALAS unsigned char* kbuf, const bf16x8 (&qr)[4], int r32, int hi, const f32x16& cinit) {
    const int sw = (r32 >> 1) & 7;
#pragma unroll
    for (int d0 = 0; d0 < 4; ++d0) { const int ch = 2 * d0 + hi;
        const bf16x8 a0 = *(const ALAS bf16x8*)(kbuf + r32 * 128 + ((ch ^ sw) << 4));
        const bf16x8 a1 = *(const ALAS bf16x8*)(kbuf + (r32 + 32) * 128 + ((ch ^ sw) << 4));
        p0 = __builtin_amdgcn_mfma_f32_32x32x16_bf16(a0, qr[d0], d0 == 0 ? cinit : p0, 0, 0, 0);
        p1 = __builtin_amdgcn_mfma_f32_32x32x16_bf16(a1, qr[d0], d0 == 0 ? cinit : p1, 0, 0, 0); }
}
__device__ __forceinline__ float max3f(float a, float b, float c) { float r; asm("v_max3_f32 %0, %1, %2, %3" : "=v"(r) : "v"(a), "v"(b), "v"(c)); return r; }
__device__ __forceinline__ void pv_tile(f32x16 (&o)[2], const ALAS unsigned char* vbuf, const f32x16& p0, const f32x16& p1, int lane, int hi) {
    u32x4 pw[4];
#pragma unroll
    for (int k = 0; k < 2; ++k) { pw[k] = (u32x4){cvtpk(p0[8 * k + 0], p0[8 * k + 1]), cvtpk(p0[8 * k + 2], p0[8 * k + 3]), cvtpk(p0[8 * k + 4], p0[8 * k + 5]), cvtpk(p0[8 * k + 6], p0[8 * k + 7])};
        pw[2 + k] = (u32x4){cvtpk(p1[8 * k + 0], p1[8 * k + 1]), cvtpk(p1[8 * k + 2], p1[8 * k + 3]), cvtpk(p1[8 * k + 4], p1[8 * k + 5]), cvtpk(p1[8 * k + 6], p1[8 * k + 7])}; }
    const ALAS unsigned char* vp = vbuf + ((lane >> 4) & 1) * 32 + (lane & 3) * 8 + (4 * hi + ((lane & 15) >> 2)) * 64;
#pragma unroll
    for (int d0 = 0; d0 < 2; ++d0)
#pragma unroll
        for (int ks = 0; ks < 4; ++ks) { const s16x4 lo = vtr(vp + d0 * VHALF + ks * 1024), hh = vtr(vp + d0 * VHALF + ks * 1024 + 512);
            const bf16x8 vb = (bf16x8){lo[0], lo[1], lo[2], lo[3], hh[0], hh[1], hh[2], hh[3]};
            o[d0] = __builtin_amdgcn_mfma_f32_32x32x16_bf16(__builtin_bit_cast(bf16x8, pw[ks]), vb, o[d0], 0, 0, 0); }
}
__device__ __forceinline__ void store_o(const f32x16 (&o)[2], ALAS unsigned char* lds, int wid, int lane, int r32, int hi, bf16_t* Og  , bool scaled) {
    ALAS float* wsf = (ALAS float*)(lds + L_WSF) + wid * 64;
    ALAS bf16_t* stg = (ALAS bf16_t*)(lds + L_OST) + wid * 2048;
#pragma unroll
    for (int r = 0; r < 16; ++r) { const int orow = crow(r, hi); const float sc = scaled ? wsf[orow] : 1.0f;
#pragma unroll
        for (int d0 = 0; d0 < 2; ++d0) { const unsigned w = cvtpk(o[d0][r] * sc, 0.f); stg[orow * 64 + d0 * 32 + r32] = (bf16_t)(w & 0xffffu); } }
    asm volatile("s_waitcnt lgkmcnt(0)" ::: "memory");
#pragma unroll
    for (int i = 0; i < 4; ++i) { const int row = i * 8 + (lane >> 3), ch = lane & 7; const u32x4 v = *(const ALAS u32x4*)(stg + row * 64 + ch * 8); *(u32x4*)(Og + (size_t)row * DM + ch * 8) = v; }
    asm volatile("s_waitcnt lgkmcnt(0)" ::: "memory");
}

__device__ __forceinline__ void chunk_prefetch(int b, int hp, int qblk, const bf16_t* Q, const bf16_t* K, const bf16_t* V, bf16x8 (&qn)[4], Stage& Sn, const int tid) {
    const int lane = tid & 63, r32 = lane & 31, hi = lane >> 5, wid = __builtin_amdgcn_readfirstlane(tid >> 6), half = wid >> 2, w4 = wid & 3, t256 = tid & 255;
    const int hcol = (2 * hp + half) * 64; const long tokb = (long)b * SEQ;
    const int cq = 2 * qblk + (w4 >> 1), tq0 = cq * 64 + (w4 & 1) * 32, kc_lo = (2 * qblk - 8) > 0 ? (2 * qblk - 8) : 0;
#pragma unroll
    for (int d0 = 0; d0 < 4; ++d0) qn[d0] = *(const bf16x8*)(Q + (size_t)(tokb + tq0 + r32) * DM + hcol + d0 * 16 + hi * 8);
    stage_load(Sn, K, V, tokb + (long)kc_lo * 64, hcol, t256);
}
__device__ __forceinline__ void chunk_attn_unit(int b, int hp, int qblk, int qblk_next, bf16x8 (&qn)[4], Stage& Sn, const bf16_t* Q, const bf16_t* K, const bf16_t* V, bf16_t* O, const float* rel, ALAS unsigned char* lds, const int tid) {
    const int lane = tid & 63, r32 = lane & 31, hi = lane >> 5, wid = __builtin_amdgcn_readfirstlane(tid >> 6), half = wid >> 2, w4 = wid & 3, t256 = tid & 255;
    const int h = 2 * hp + half, hcol = h * 64; const long tokb = (long)b * SEQ;
    const int cq = 2 * qblk + (w4 >> 1), iq0 = (w4 & 1) * 32, tq0 = cq * 64 + iq0;
    ALAS float* wsf = (ALAS float*)(lds + L_WSF) + wid * 64;
    ALAS float* tab = (ALAS float*)(lds + L_TAB) + half * 260;
    bf16x8 qr[4];
#pragma unroll
    for (int d0 = 0; d0 < 4; ++d0) qr[d0] = qn[d0];
    for (int i = t256; i < 257; i += 256) tab[i] = rel[i * 16 + h] * LOG2E;
    const int kc_lo = (2 * qblk - 8) > 0 ? (2 * qblk - 8) : 0, n = 2 * qblk + 1 - kc_lo + 1;
    Stage S0 = Sn, S1;
    stage_store(S0, lds + L_KV + ((0 * 2 + half) * 2 + 0) * 8192, lds + L_KV + ((0 * 2 + half) * 2 + 1) * 8192, t256);
    if (n > 1) stage_load(S0, K, V, tokb + (long)(kc_lo + 1) * 64, hcol, t256);
    if (n > 2) stage_load(S1, K, V, tokb + (long)(kc_lo + 2) * 64, hcol, t256);
    __syncthreads();
    float mrun = -INFINITY, lrun = 0.f; f32x16 o[2]; o[0] = (f32x16){}; o[1] = (f32x16){};
    const f32x16 zero16 = {}; f32x16 bcv; { const float bc = tab[256];
#pragma unroll
        for (int r = 0; r < 16; ++r) bcv[r] = bc; }
    auto compute = [&](const int i, const int bufc) __attribute__((always_inline)) { const int kc = kc_lo + i;
        if (kc >= cq - 8 && kc <= cq) {
            const ALAS unsigned char* kbuf = lds + L_KV + ((bufc * 2 + half) * 2 + 0) * 8192; const ALAS unsigned char* vbuf = kbuf + 8192;
            f32x16 p0, p1;
            const int delta = cq - kc;
            if (delta >= 3) qk_tile(p0, p1, kbuf, qr, r32, hi, bcv);
            else { qk_tile(p0, p1, kbuf, qr, r32, hi, zero16);
                const int base = delta * 64 + iq0 + r32 + 128;
#pragma unroll
                for (int r = 0; r < 16; ++r) { const int i0 = base - crow(r, hi), i1 = i0 - 32; p0[r] += tab[i0 > 256 ? 256 : i0]; p1[r] += tab[i1 > 256 ? 256 : i1]; } }
            float mx = max3f(p0[0], p1[0], p0[1]);
#pragma unroll
            for (int r = 1; r < 15; ++r) mx = max3f(mx, p1[r], p0[r + 1]);
            mx = fmaxf(mx, p1[15]);
            mx = fmaxf(mx, __shfl_xor(mx, 32));
            const float mn = fmaxf(mrun, mx), f = __builtin_amdgcn_exp2f(mrun - mn); mrun = mn;
#pragma unroll
            for (int r = 0; r < 16; ++r) { p0[r] = __builtin_amdgcn_exp2f(p0[r] - mn); p1[r] = __builtin_amdgcn_exp2f(p1[r] - mn); }
            const f32x16 ps = p0 + p1;
            float rs = ((ps[0] + ps[1]) + (ps[2] + ps[3])) + ((ps[4] + ps[5]) + (ps[6] + ps[7])) + (((ps[8] + ps[9]) + (ps[10] + ps[11])) + ((ps[12] + ps[13]) + (ps[14] + ps[15])));
            rs += __shfl_xor(rs, 32);
            lrun = lrun * f + rs;
            if (__any(f != 1.0f)) { if (hi == 0) wsf[r32] = f; asm volatile("s_waitcnt lgkmcnt(0)" ::: "memory");
#pragma unroll
                for (int r = 0; r < 16; ++r) { const float ff = wsf[crow(r, hi)]; o[0][r] *= ff; o[1][r] *= ff; }
                asm volatile("s_waitcnt lgkmcnt(0)" ::: "memory"); }
            pv_tile(o, vbuf, p0, p1, lane, hi);
        }
    };
#define ATT_STEP(ii, bufc, SX) do { compute((ii), (bufc)); \
        if ((ii) + 1 < n) stage_store(SX, lds + L_KV + ((((bufc) ^ 1) * 2 + half) * 2 + 0) * 8192, lds + L_KV + ((((bufc) ^ 1) * 2 + half) * 2 + 1) * 8192, t256); \
        if ((ii) + 3 < n) stage_load(SX, K, V, tokb + (long)(kc_lo + (ii) + 3) * 64, hcol, t256); \
        __syncthreads(); } while (0)
    for (int i = 0; i < n; i += 2) { ATT_STEP(i, 0, S0); if (i + 1 < n) ATT_STEP(i + 1, 1, S1); }
#undef ATT_STEP
    if (qblk_next >= 0) chunk_prefetch(b, hp, qblk_next, Q, K, V, qn, Sn, tid);
    if (hi == 0) wsf[r32] = 1.0f / lrun;
    asm volatile("s_waitcnt lgkmcnt(0)" ::: "memory");
    store_o(o, lds, wid, lane, r32, hi, O + (size_t)(tokb + tq0) * DM + hcol, true);
}

__device__ __forceinline__ void stick_prefetch(int b, int hp, int qb, const bf16_t* Q, const bf16_t* K, const bf16_t* V, bf16x8 (&qn)[4], Stage& Sn, const int tid) {
    const int lane = tid & 63, r32 = lane & 31, hi = lane >> 5, wid = __builtin_amdgcn_readfirstlane(tid >> 6), half = wid >> 2, w4 = wid & 3, t256 = tid & 255;
    const int hcol = (2 * hp + half) * 64; const long tokb = (long)b * SEQ; const int tq = qb * 128 + w4 * 32 + r32, n = 2 * qb + 2;
#pragma unroll
    for (int d0 = 0; d0 < 4; ++d0) qn[d0] = *(const bf16x8*)(Q + (size_t)(tokb + tq) * DM + hcol + d0 * 16 + hi * 8);
    stage_load(Sn, K, V, tokb + (long)(n - 1) * 64, hcol, t256);
}
__device__ __forceinline__ void stick_attn_unit(int b, int hp, int qb, int qb_next, bf16x8 (&qn)[4], Stage& Sn, const bf16_t* Q, const bf16_t* K, const bf16_t* V, bf16_t* O, ALAS unsigned char* lds, const int tid) {
    const int lane = tid & 63, r32 = lane & 31, hi = lane >> 5, wid = __builtin_amdgcn_readfirstlane(tid >> 6), half = wid >> 2, w4 = wid & 3, t256 = tid & 255;
    const int h = 2 * hp + half, hcol = h * 64; const long tokb = (long)b * SEQ;
    const int tq0 = qb * 128 + w4 * 32, tq = tq0 + r32;
    ALAS unsigned* flg = (ALAS unsigned*)(lds + L_FLAG);
    bf16x8 qr[4];
#pragma unroll
    for (int d0 = 0; d0 < 4; ++d0) qr[d0] = qn[d0];
    const int n = 2 * qb + 2;
    Stage S0 = Sn, S1;
    stage_store(S0, lds + L_KV + ((0 * 2 + half) * 2 + 0) * 8192, lds + L_KV + ((0 * 2 + half) * 2 + 1) * 8192, t256);
    stage_load(S0, K, V, tokb + (long)(n - 2) * 64, hcol, t256);
    if (n > 2) stage_load(S1, K, V, tokb + (long)(n - 3) * 64, hcol, t256);
    __syncthreads();
    float carry = 0.f; f32x16 o[2]; o[0] = (f32x16){}; o[1] = (f32x16){};
    auto compute = [&](const int i, const int bufc) __attribute__((always_inline)) { const int kt = n - 1 - i, k0 = kt * 64;
        if (k0 < tq0 + 31) {
            const ALAS unsigned char* kbuf = lds + L_KV + ((bufc * 2 + half) * 2 + 0) * 8192; const ALAS unsigned char* vbuf = kbuf + 8192;
            f32x16 p0, p1; { const f32x16 zero16 = {}; qk_tile(p0, p1, kbuf, qr, r32, hi, zero16); }
            const bool needmask = (k0 + 63 >= tq0);
            f32x16 L0, L1;
#pragma unroll
            for (int r = 0; r < 16; ++r) {
                { const float zz = p0[r], e = __builtin_amdgcn_exp2f(-fabsf(zz)), lsp = __builtin_amdgcn_logf(1.0f + e); float lb = fminf(zz, 0.f) - lsp, l1 = lb - zz;
                  if (needmask && (k0 + crow(r, hi) >= tq)) { lb = -INFINITY; l1 = 0.f; } p0[r] = lb; L0[r] = l1; }
                { const float zz = p1[r], e = __builtin_amdgcn_exp2f(-fabsf(zz)), lsp = __builtin_amdgcn_logf(1.0f + e); float lb = fminf(zz, 0.f) - lsp, l1 = lb - zz;
                  if (needmask && (k0 + 32 + crow(r, hi) >= tq)) { lb = -INFINITY; l1 = 0.f; } p1[r] = lb; L1[r] = l1; }
            }
            float g0[4], g1[4], pg0[4], pg1[4];
#pragma unroll
            for (int g = 0; g < 4; ++g) { g0[g] = (L0[4 * g] + L0[4 * g + 1]) + (L0[4 * g + 2] + L0[4 * g + 3]); g1[g] = (L1[4 * g] + L1[4 * g + 1]) + (L1[4 * g + 2] + L1[4 * g + 3]); }
#pragma unroll
            for (int g = 0; g < 4; ++g) { pg0[g] = __shfl_xor(g0[g], 32); pg1[g] = __shfl_xor(g1[g], 32); }
            float suff = 0.f;
#pragma unroll
            for (int g = 3; g >= 0; --g) { const float e3 = carry + suff + (hi == 0 ? pg1[g] : 0.f), e2 = e3 + L1[4 * g + 3], e1 = e2 + L1[4 * g + 2], e0 = e1 + L1[4 * g + 1];
                p1[4 * g + 3] = __builtin_amdgcn_exp2f(p1[4 * g + 3] + e3); p1[4 * g + 2] = __builtin_amdgcn_exp2f(p1[4 * g + 2] + e2);
                p1[4 * g + 1] = __builtin_amdgcn_exp2f(p1[4 * g + 1] + e1); p1[4 * g + 0] = __builtin_amdgcn_exp2f(p1[4 * g + 0] + e0);
                suff += g1[g] + pg1[g]; }
            carry += suff; suff = 0.f;
#pragma unroll
            for (int g = 3; g >= 0; --g) { const float e3 = carry + suff + (hi == 0 ? pg0[g] : 0.f), e2 = e3 + L0[4 * g + 3], e1 = e2 + L0[4 * g + 2], e0 = e1 + L0[4 * g + 1];
                p0[4 * g + 3] = __builtin_amdgcn_exp2f(p0[4 * g + 3] + e3); p0[4 * g + 2] = __builtin_amdgcn_exp2f(p0[4 * g + 2] + e2);
                p0[4 * g + 1] = __builtin_amdgcn_exp2f(p0[4 * g + 1] + e1); p0[4 * g + 0] = __builtin_amdgcn_exp2f(p0[4 * g + 0] + e0);
                suff += g0[g] + pg0[g]; }
            carry += suff;
            pv_tile(o, vbuf, p0, p1, lane, hi);
        }
    };
    bool stop = false;
#define ATT_STEP(ii, bufc, SX) do { compute((ii), (bufc)); \
        { const int alld = __all(carry < -150.0f); if (lane == 0) flg[(bufc) * 8 + wid] = (unsigned)alld; } \
        if ((ii) + 1 < n) stage_store(SX, lds + L_KV + ((((bufc) ^ 1) * 2 + half) * 2 + 0) * 8192, lds + L_KV + ((((bufc) ^ 1) * 2 + half) * 2 + 1) * 8192, t256); \
        if ((ii) + 3 < n) stage_load(SX, K, V, tokb + (long)(n - 1 - ((ii) + 3)) * 64, hcol, t256); \
        __syncthreads(); \
        { const ALAS u32x4* fp = (const ALAS u32x4*)(flg + (bufc) * 8); const u32x4 f0 = fp[0], f1 = fp[1]; \
          stop = (f0[0] & f0[1] & f0[2] & f0[3] & f1[0] & f1[1] & f1[2] & f1[3]) != 0u; } } while (0)
    for (int i = 0; i < n; i += 2) { ATT_STEP(i, 0, S0); if (stop) break; if (i + 1 < n) { ATT_STEP(i + 1, 1, S1); if (stop) break; } }
#undef ATT_STEP
    if (qb_next >= 0) stick_prefetch(b, hp, qb_next, Q, K, V, qn, Sn, tid);
    store_o(o, lds, wid, lane, r32, hi, O + (size_t)(tokb + tq0) * DM + hcol, false);
}
#undef ALAS
}

#define GAS __attribute__((address_space(1)))
#define LAS __attribute__((address_space(3)))
typedef unsigned short bf16;
typedef unsigned v4u __attribute__((ext_vector_type(4)));
typedef float f32x4 __attribute__((ext_vector_type(4)));
typedef short bf16x8 __attribute__((ext_vector_type(8)));
typedef GAS unsigned gu32;
typedef GAS unsigned long long gu64;
#define RLX_AGENT __ATOMIC_RELAXED, __HIP_MEMORY_SCOPE_AGENT
#define LDS_WAIT() asm volatile("s_waitcnt lgkmcnt(0)" ::: "memory")
#define VM_WAIT() asm volatile("s_waitcnt vmcnt(0)" ::: "memory")
__device__ __forceinline__ unsigned long long rt() { return __builtin_amdgcn_s_memrealtime(); }
__device__ __forceinline__ unsigned f2bf(float f) { unsigned u = __builtin_bit_cast(unsigned, f); return (u + 0x7fffu + ((u >> 16) & 1u)) >> 16; }
__device__ __forceinline__ unsigned pk2(float lo, float hi) { return f2bf(lo) | (f2bf(hi) << 16); }

#define XB_TMO      128
#define XB_XCNT(j)  (256  + 64 * (j))
#define XB_XSUB(j)  (1280 + 64 * (j))
#define XB_XGEN(j)  (2304 + 64 * (j))
#define XB_TOP      3328
#define XB_TOPGEN   3392
#define XCD_BAR_WORDS 3456
#define XB_SPIN_CAP (1u << 18)

__device__ __forceinline__ unsigned xb_ld(unsigned* p)              { return __hip_atomic_load(p, __ATOMIC_RELAXED, __HIP_MEMORY_SCOPE_AGENT); }
__device__ __forceinline__ unsigned xb_add(unsigned* p, unsigned v) { return __hip_atomic_fetch_add(p, v, __ATOMIC_RELAXED, __HIP_MEMORY_SCOPE_AGENT); }
__device__ __forceinline__ unsigned xb_xcc_id() { return (unsigned)__builtin_amdgcn_s_getreg((3 << 11) | 20) & 0xFu; }
#define XB_SPIN(cond, bar) do { unsigned _sp = 0; while (cond) { __builtin_amdgcn_s_sleep(1); \
    if ((++_sp & 255u) == 0u) { if (xb_ld(&(bar)[XB_TMO])) break; if (_sp > XB_SPIN_CAP) { atomicAdd(&(bar)[XB_TMO], 1u); break; } } } } while (0)

struct XcdBarrier {
    unsigned* bar; unsigned x;
    volatile LAS unsigned* st;
};

__device__ __forceinline__ XcdBarrier xcd_barrier_post(unsigned* bar, volatile LAS unsigned* st) {
    XcdBarrier b; b.bar = bar; b.x = xb_xcc_id(); b.st = st;
    if (threadIdx.x == 0) (void)xb_add(&bar[XB_XCNT(b.x)], 1u);
    return b;
}
__device__ __forceinline__ void xcd_barrier_complete(unsigned* bar, unsigned x, unsigned& nloc, unsigned& nx) {
    const unsigned G = gridDim.x * gridDim.y * gridDim.z;
    unsigned sum, cnt, mine, sp = 0u;
    for (;;) {
        sum = 0u; cnt = 0u; mine = 0u;
#pragma unroll
        for (unsigned j = 0; j < 16; ++j) { const unsigned c = xb_ld(&bar[XB_XCNT(j)]); sum += c; cnt += (c > 0u) ? 1u : 0u; mine = (j == x) ? c : mine; }
        if (sum == G) break;
        __builtin_amdgcn_s_sleep(1);
        if ((++sp & 255u) == 0u) { if (xb_ld(&bar[XB_TMO])) break; if (sp > XB_SPIN_CAP) { atomicAdd(&bar[XB_TMO], 1u); break; } }
    }
    nloc = mine > 0u ? mine : 1u; nx = cnt > 0u ? cnt : 1u;
}

__device__ __forceinline__ void xcd_barrier(const XcdBarrier& b) {
    asm volatile("s_waitcnt vmcnt(0)" ::: "memory");
    __syncthreads();
    if (threadIdx.x == 0) {
        unsigned* bar = b.bar;
        __builtin_amdgcn_s_waitcnt(0);
        unsigned nloc = b.st[0], nx = b.st[1];
        if (nloc == 0u) { xcd_barrier_complete(bar, b.x, nloc, nx); b.st[0] = nloc; b.st[1] = nx; }
        const unsigned old = xb_add(&bar[XB_XSUB(b.x)], 1u);
        const unsigned gen = old / nloc;
        if (old + 1u == (gen + 1u) * nloc) {
            __builtin_amdgcn_fence(__ATOMIC_RELEASE, "agent");
            asm volatile("s_waitcnt vmcnt(0)" ::: "memory");
            const unsigned og = xb_add(&bar[XB_TOP], 1u);
            const unsigned tg = og / nx;
            if (og + 1u == (tg + 1u) * nx) xb_add(&bar[XB_TOPGEN], 1u);
            else XB_SPIN(xb_ld(&bar[XB_TOPGEN]) == tg, bar);
            __builtin_amdgcn_fence(__ATOMIC_ACQUIRE, "agent");
            xb_add(&bar[XB_XGEN(b.x)], 1u);
            asm volatile("s_waitcnt vmcnt(0)" ::: "memory");
        } else {
            XB_SPIN(xb_ld(&bar[XB_XGEN(b.x)]) == gen, bar);
            __builtin_amdgcn_fence(__ATOMIC_ACQUIRE, "agent");
            asm volatile("s_waitcnt vmcnt(0)" ::: "memory");
        }
    }
    __syncthreads();
}
constexpr int NWAVES = 8;
constexpr int BATCH = 16, SEQ = 2048, D = 1024, FF = 2816, DEPTH = 4, M = BATCH * SEQ;
constexpr size_t MiB = 1u << 20;
constexpr size_t WS_CTL = 0, CTL_ZERO_BYTES = 4 * MiB;
constexpr int CW_BAR = 1024;
constexpr size_t WS_CS = 64 * 1024, WS_BW = 320 * 1024;
constexpr int CSV_QKV = 8 * 2 * FF;
constexpr size_t WS_IDSTAT = 640 * 1024;
constexpr size_t WS_STAT = 1 * MiB;
constexpr size_t WS_W1 = 4 * MiB;
constexpr size_t WS_W2 = WS_W1 + 88 * MiB;
constexpr size_t WS_WQKV = WS_W2 + 44 * MiB;
constexpr size_t WS_WO = WS_WQKV + 24 * MiB;
constexpr size_t WS_ZB = WS_WO + 8 * MiB;
constexpr size_t WS_QKV = WS_ZB + 64 * MiB;
constexpr size_t WS_Z16 = WS_QKV + 192 * MiB;
constexpr size_t WS_END = WS_Z16 + 64 * MiB;
constexpr int LDS_STAGE = 131072, GB_OFF = LDS_STAGE, MISC_OFF = GB_OFF + 8192, STASH_OFF = MISC_OFF + 512, LDS_BYTES = STASH_OFF + 4096;


typedef _Float16 h2_t __attribute__((ext_vector_type(2)));
__device__ __forceinline__ unsigned pk2h(float lo, float hi) { const h2_t h = (h2_t){(_Float16)lo, (_Float16)hi}; return __builtin_bit_cast(unsigned, h); }
__device__ __forceinline__ void transpose_item(const float* W, int N, bf16* WT, int Kt, int k0, int n0, int dst_row0, const float* gvec, const float* bvec, float* cs, float* bw, LAS float* scr, int lane, const bool f16out) {
    float csp[4] = {0.f, 0.f, 0.f, 0.f}, bwp[4] = {0.f, 0.f, 0.f, 0.f};
    const int c4 = lane & 7, kq = lane >> 3;
    f32x4 wv[8]; float gk[8], bk[8];
#pragma unroll
    for (int i = 0; i < 8; ++i) wv[i] = *(const f32x4*)(W + (size_t)(k0 + 8 * i + kq) * N + n0 + 4 * c4);
    if (gvec) {
#pragma unroll
        for (int i = 0; i < 8; ++i) { gk[i] = gvec[k0 + 8 * i + kq]; bk[i] = bvec[k0 + 8 * i + kq]; }
    } else {
#pragma unroll
        for (int i = 0; i < 8; ++i) { gk[i] = 1.0f; bk[i] = 0.0f; }
    }
#pragma unroll
    for (int i = 0; i < 8; ++i) { const int kk = 8 * i + kq;
#pragma unroll
        for (int j = 0; j < 4; ++j) { float wsc = wv[i][j] * gk[i]; if (f16out) wsc = __builtin_bit_cast(float, f2bf(wsc) << 16);     scr[kk * 33 + 4 * c4 + j] = wsc; csp[j] += f16out ? (float)(_Float16)wsc : __builtin_bit_cast(float, f2bf(wsc) << 16); bwp[j] += bk[i] * wv[i][j]; } }
    if (cs) {
#pragma unroll
        for (int j = 0; j < 4; ++j) { csp[j] += __shfl_xor(csp[j], 8); csp[j] += __shfl_xor(csp[j], 16); csp[j] += __shfl_xor(csp[j], 32); bwp[j] += __shfl_xor(bwp[j], 8); bwp[j] += __shfl_xor(bwp[j], 16); bwp[j] += __shfl_xor(bwp[j], 32); }
        if (lane < 8) {
#pragma unroll
            for (int j = 0; j < 4; ++j) { unsafeAtomicAdd(cs + dst_row0 + 4 * c4 + j, csp[j]); unsafeAtomicAdd(bw + dst_row0 + 4 * c4 + j, bwp[j]); } } }
    LDS_WAIT(); asm volatile("" ::: "memory");
    const int c = lane & 7;
#pragma unroll
    for (int j = 0; j < 4; ++j) { const int n = (lane >> 3) + 8 * j; const LAS float* s = scr + (8 * c) * 33 + n;
        v4u o; if (f16out) { o.x = pk2h(s[0 * 33], s[1 * 33]); o.y = pk2h(s[2 * 33], s[3 * 33]); o.z = pk2h(s[4 * 33], s[5 * 33]); o.w = pk2h(s[6 * 33], s[7 * 33]); }
        else { o.x = pk2(s[0 * 33], s[1 * 33]); o.y = pk2(s[2 * 33], s[3 * 33]); o.z = pk2(s[4 * 33], s[5 * 33]); o.w = pk2(s[6 * 33], s[7 * 33]); }
        *(v4u*)(WT + (size_t)(dst_row0 + n) * Kt + k0 + 8 * c) = o; }
    LDS_WAIT(); asm volatile("" ::: "memory");
}
__device__ __forceinline__ float wave_sum(float v) {
#pragma unroll
    for (int o = 1; o < 64; o <<= 1) v += __shfl_xor(v, o);
    return v;
}

#ifndef PROBE_GROUP
#define PROBE_GROUP 0
#endif
#define PROBE_T0(grp) unsigned long long pt0_ = 0; if (PROBE_GROUP == (grp)) pt0_ = __builtin_amdgcn_s_memrealtime();
#define PROBE_T1(grp) if (PROBE_GROUP == (grp)) { const unsigned long long pt1_ = __builtin_amdgcn_s_memrealtime(); while (__builtin_amdgcn_s_memrealtime() - pt1_ < pt1_ - pt0_) __builtin_amdgcn_s_sleep(8); }
#ifndef GEMM_F16
#define GEMM_F16 true
#endif
struct Args { const float* in[11]; float* out; unsigned char* ws; };

__global__ void __launch_bounds__(NWAVES * 64, 2) fwd_megakernel(Args args) {
    extern __shared__ __attribute__((aligned(16))) unsigned char lds_raw[];
    LAS unsigned char* lds = (LAS unsigned char*)lds_raw;
    volatile LAS unsigned* MISC = (volatile LAS unsigned*)(lds + MISC_OFF);
    const int wave = __builtin_amdgcn_readfirstlane(threadIdx.x >> 6);
    const int G = gridDim.x, bx = blockIdx.x;
    unsigned char* ws = args.ws;
    unsigned* ctl = (unsigned*)(ws + WS_CTL);
    const float* x_in = args.in[0]; const float* rel = args.in[3]; const float* ln_g = args.in[9]; const float* ln_b = args.in[10];
    float* zout = args.out;
    float* IDSTAT = (float*)(ws + WS_IDSTAT);
    float* CS = (float*)(ws + WS_CS); float* BW = (float*)(ws + WS_BW); float* STAT = (float*)(ws + WS_STAT);
    bf16* W1T = (bf16*)(ws + WS_W1); bf16* W2T = (bf16*)(ws + WS_W2); bf16* WQKVT = (bf16*)(ws + WS_WQKV); bf16* WOT = (bf16*)(ws + WS_WO);
    _Float16* Z16 = GEMM_F16 ? (_Float16*)(ws + WS_ZB) : (_Float16*)(ws + WS_Z16);
    bf16* ZB = (bf16*)(ws + WS_ZB); bf16* QB = (bf16*)(ws + WS_QKV); bf16* KB = QB + (size_t)M * D; bf16* VB = KB + (size_t)M * D; bf16* HB = QB;
    for (int u = threadIdx.x; u < (STASH_OFF - MISC_OFF) / 4; u += NWAVES * 64) ((LAS unsigned*)(lds + MISC_OFF))[u] = 0u;
    __syncthreads();
    XcdBarrier bar = xcd_barrier_post(ctl + CW_BAR, MISC + 8);

    {
        PROBE_T0(3)
        const int tid = threadIdx.x, lane = tid & 63;
        LAS float* scr = (LAS float*)(lds + wave * 16384);
        const int gw = bx * NWAVES + wave, NGW = G * NWAVES;
        constexpr int I_F = 16 * 88, N_FFN = 8 * 3 * I_F, I_QKV = 16 * 96, I_O = 16 * 32, N_MIX = 4 * (I_QKV + I_O);
        for (int it = gw; it < N_FFN + N_MIX; it += NGW) {
            if (it < N_FFN) { const int mi = it / I_F, r = it % I_F, f = mi / 3, which = mi % 3;
                if (which < 2) { const int kb = r / 88, nb = r % 88, n0 = 32 * nb, s = 3 * (f >> 1) + 2 * (f & 1);
                    const float* W = args.in[6 + which] + (size_t)f * D * FF;
                    const int dst = (n0 >> 7) * 256 + (n0 & 127) + which * 128;
                    transpose_item(W, FF, W1T + (size_t)f * 2 * FF * D, D, 64 * kb, n0, dst, s > 0 ? ln_g + (s - 1) * D : nullptr, s > 0 ? ln_b + (s - 1) * D : nullptr, CS + f * 2 * FF, BW + f * 2 * FF, scr, lane, GEMM_F16);
                } else { const int kb = r / 32, nb = r % 32;
                    transpose_item(args.in[8] + (size_t)f * FF * D, D, W2T + (size_t)f * D * FF, FF, 64 * kb, 32 * nb, 32 * nb, nullptr, nullptr, nullptr, nullptr, scr, lane, false); }
            } else { const int it2 = it - N_FFN, li = it2 / (I_QKV + I_O), r = it2 % (I_QKV + I_O), j = li >> 1, s = 3 * li + 1;
                if (r < I_QKV) { const int kb = r / 96, nb = r % 96;
                    const float* W = args.in[(li & 1) ? 4 : 1] + (size_t)j * D * 3 * D;
                    transpose_item(W, 3 * D, WQKVT + (size_t)li * 3 * D * D, D, 64 * kb, 32 * nb, 32 * nb, ln_g + (s - 1) * D, ln_b + (s - 1) * D, CS + CSV_QKV + li * 3 * D, BW + CSV_QKV + li * 3 * D, scr, lane, GEMM_F16);
                } else { const int r2 = r - I_QKV, kb = r2 / 32, nb = r2 % 32;
                    const float* W = args.in[(li & 1) ? 5 : 2] + (size_t)j * D * D;
                    transpose_item(W, D, WOT + (size_t)li * D * D, D, 64 * kb, 32 * nb, 32 * nb, nullptr, nullptr, nullptr, nullptr, scr, lane, false); }
            }
        }
        for (int r = bx * (NWAVES * 64) + tid; r < M; r += G * NWAVES * 64) { IDSTAT[2 * r] = 0.0f; IDSTAT[2 * r + 1] = 1024.0f * (1.0f - 1e-5f); }
        const size_t nch = (size_t)M * D / 8, nthr = (size_t)G * NWAVES * 64;
        size_t c = (size_t)bx * (NWAVES * 64) + tid;
        for (; c + 3 * nthr < nch; c += 4 * nthr) {
            f32x4 a[4], b[4];
#pragma unroll
            for (int j = 0; j < 4; ++j) { a[j] = *(const f32x4*)(x_in + (c + j * nthr) * 8); b[j] = *(const f32x4*)(x_in + (c + j * nthr) * 8 + 4); }
#pragma unroll
            for (int j = 0; j < 4; ++j) { v4u o; o.x = pk2h(a[j][0], a[j][1]); o.y = pk2h(a[j][2], a[j][3]); o.z = pk2h(b[j][0], b[j][1]); o.w = pk2h(b[j][2], b[j][3]); *(v4u*)(ZB + (c + j * nthr) * 8) = o; } }
        for (; c < nch; c += nthr) { const f32x4 a = *(const f32x4*)(x_in + c * 8), b = *(const f32x4*)(x_in + c * 8 + 4);
            v4u o; o.x = pk2h(a[0], a[1]); o.y = pk2h(a[2], a[3]); o.z = pk2h(b[0], b[1]); o.w = pk2h(b[2], b[3]); *(v4u*)(ZB + c * 8) = o; }
        PROBE_T1(3)
    }
    __syncthreads();
    cg::this_grid().sync();

#define GRID_BAR() do { PROBE_T0(4) xcd_barrier(bar); PROBE_T1(4) } while (0)
#define GRID_BAR_C(cls) do { PROBE_T0(cls) xcd_barrier(bar); PROBE_T1(cls) } while (0)
#pragma unroll 1
    for (int li_ = 0; li_ < DEPTH; ++li_) {
#pragma unroll 1
        for (int sub_ = 0; sub_ < 3; ++sub_) {
            int li = li_, sub = sub_; asm volatile("" : "+s"(li), "+s"(sub)); unsigned zv_; asm volatile("v_mov_b32 %0, 0" : "=v"(zv_)); int tidv = wave * 64 + (int)__builtin_amdgcn_mbcnt_hi(~0u, __builtin_amdgcn_mbcnt_lo(~0u, zv_)); asm volatile("" : "+v"(tidv));
            const int s = 3 * li + sub;
            const float* stat_in = s > 0 ? STAT + (size_t)(s - 1) * M * 2 : IDSTAT;
            float* stat_out = STAT + (size_t)s * M * 2;
            const float* gin = ln_g + (s > 0 ? s - 1 : 0) * D; const float* bin = ln_b + (s > 0 ? s - 1 : 0) * D;
            { LAS float* gbw = (LAS float*)(lds + GB_OFF); for (int c = tidv; c < D; c += NWAVES * 64) { gbw[c] = s > 0 ? gin[c] : 1.0f; gbw[D + c] = s > 0 ? bin[c] : 0.0f; } }
            __syncthreads();
            if (sub != 1) {
                const int f = 2 * li + (sub >> 1);
                { PROBE_T0(1) pg8::Gemm g{ZB, W1T + (size_t)f * 2 * FF * D, M, 2 * FF, D}; pg8::StaticOrder S; S.init(M, 2 * FF, G, bx);
                  pg8::EpiSwiglu E{HB, stat_in, CS + f * 2 * FF, BW + f * 2 * FF, (LAS float*)(lds + STASH_OFF)};
                  asm volatile("" : "+v"(tidv)); pg8::gemm_phase<pg8::EpiSwiglu, pg8::StaticOrder, true, true, GEMM_F16>(lds, tidv, g, S, E); PROBE_T1(1) }
                GRID_BAR_C(11);
                { PROBE_T0(1) pg8::Gemm g{HB, W2T + (size_t)f * D * FF, M, D, FF}; pg8::StaticOrder S; S.init(M, D, G, bx, 1);
                  pg8::EpiResid E{Z16, stat_in, (const LAS float*)(lds + GB_OFF), stat_out, 0.5f};
                  asm volatile("" : "+v"(tidv)); pg8::gemm_phase<pg8::EpiResid, pg8::StaticOrder, true, true>(lds, tidv, g, S, E); PROBE_T1(1) }
                GRID_BAR_C(12);
            } else {
                { PROBE_T0(1) pg8::Gemm g{ZB, WQKVT + (size_t)li * 3 * D * D, M, 3 * D, D}; pg8::StaticOrder S; S.init(M, 3 * D, G, bx);
                  pg8::EpiQKV E{QB, (size_t)M * D, stat_in, CS + CSV_QKV + li * 3 * D, BW + CSV_QKV + li * 3 * D, 0.125f * 1.4426950408889634f, (LAS float*)(lds + STASH_OFF)};
                  asm volatile("" : "+v"(tidv)); pg8::gemm_phase<pg8::EpiQKV, pg8::StaticOrder, true, true, GEMM_F16>(lds, tidv, g, S, E); PROBE_T1(1) }
                GRID_BAR_C(13);
                asm volatile("" : "+v"(tidv));
                { PROBE_T0(2)
                for (int vb = bx; vb < 256; vb += G) { const int grp = vb >> 1, e = vb & 1, b = grp >> 3, hp = grp & 7;
                    att::bf16x8 qn[4]; att::Stage Sn;
                    if ((li & 1) == 0) { att::chunk_prefetch(b, hp, e ^ 1, QB, KB, VB, qn, Sn, tidv);
                        for (int i = 0; i < 8; ++i) { asm volatile("" : "+v"(tidv)); att::chunk_attn_unit(b, hp, i == 0 ? (e ^ 1) : 2 * i + e, i < 7 ? 2 * (i + 1) + e : -1, qn, Sn, QB, KB, VB, QB, rel, lds, tidv); } }
                    else { att::stick_prefetch(b, hp, e, QB, KB, VB, qn, Sn, tidv);
                        for (int i = 0; i < 8; ++i) { const int k = 2 * (i >> 1) + e, qb = (i & 1) ? 15 - k : k, i1 = i + 1, k1 = 2 * (i1 >> 1) + e, qb1 = i1 < 8 ? ((i1 & 1) ? 15 - k1 : k1) : -1;
                            asm volatile("" : "+v"(tidv)); att::stick_attn_unit(b, hp, qb, qb1, qn, Sn, QB, KB, VB, QB, lds, tidv); } } }
                PROBE_T1(2) }
                GRID_BAR_C(14);
                { PROBE_T0(1) pg8::Gemm g{QB, WOT + (size_t)li * D * D, M, D, D}; pg8::StaticOrder S; S.init(M, D, G, bx);
                  pg8::EpiResid E{Z16, stat_in, (const LAS float*)(lds + GB_OFF), stat_out, 1.0f};
                  asm volatile("" : "+v"(tidv)); pg8::gemm_phase<pg8::EpiResid, pg8::StaticOrder, true, true>(lds, tidv, g, S, E); PROBE_T1(1) }
                GRID_BAR_C(15);
            }
        }
    }
    {
        PROBE_T0(5)
        unsigned zv2_; asm volatile("v_mov_b32 %0, 0" : "=v"(zv2_)); const int lane = (int)__builtin_amdgcn_mbcnt_hi(~0u, __builtin_amdgcn_mbcnt_lo(~0u, zv2_));
        const int gw = bx * NWAVES + wave, NGW = G * NWAVES; const float* gl = ln_g + 11 * D; const float* bl = ln_b + 11 * D;
        f32x4 ggv[4], bbv[4];
#pragma unroll
        for (int j = 0; j < 4; ++j) { const int c4 = 2 * lane + (j & 1) + 128 * (j >> 1); ggv[j] = *((const f32x4*)gl + c4); bbv[j] = *((const f32x4*)bl + c4); }
        auto ln_rows = [&](const int m0, const int nr) __attribute__((always_inline)) {
            pg8::f16x8 h[2][2];
#pragma unroll
            for (int r = 0; r < 2; ++r) if (r < nr) { const pg8::f16x8* zr16 = (const pg8::f16x8*)(Z16 + (size_t)(m0 + r * NGW) * D) + lane;
                h[r][0] = zr16[0]; h[r][1] = zr16[64]; }
#pragma unroll
            for (int r = 0; r < 2; ++r) if (r < nr) { const int m = m0 + r * NGW; f32x4 v[4]; float s = 0.f;
#pragma unroll
                for (int jj = 0; jj < 2; ++jj) { v[2 * jj] = (f32x4){(float)h[r][jj][0], (float)h[r][jj][1], (float)h[r][jj][2], (float)h[r][jj][3]}; v[2 * jj + 1] = (f32x4){(float)h[r][jj][4], (float)h[r][jj][5], (float)h[r][jj][6], (float)h[r][jj][7]}; }
#pragma unroll
                for (int j = 0; j < 4; ++j) s += (v[j][0] + v[j][1]) + (v[j][2] + v[j][3]);
                const float mean = wave_sum(s) * (1.f / D); float s2 = 0.f;
#pragma unroll
                for (int j = 0; j < 4; ++j) { v[j] = v[j] - mean; s2 += (v[j][0] * v[j][0] + v[j][1] * v[j][1]) + (v[j][2] * v[j][2] + v[j][3] * v[j][3]); }
                const float rstd = 1.f / sqrtf(wave_sum(s2) * (1.f / D) + 1e-5f);
#pragma unroll
                for (int j = 0; j < 4; ++j) { const int c4 = 2 * lane + (j & 1) + 128 * (j >> 1);
                    *((f32x4*)(zout + (size_t)m * D) + c4) = v[j] * rstd * ggv[j] + bbv[j]; } }
        };
        int m = gw;
        for (; m + NGW < M; m += 2 * NGW) ln_rows(m, 2);
        if (m < M) ln_rows(m, 1);
        PROBE_T1(5)
    }
}

extern "C" void kernel_launch(void* const* d_in, const int* in_sizes, int n_in, void* d_out, int out_size, void* d_ws, size_t ws_size, hipStream_t stream) {
    static int grid = 0;
    if (grid == 0) {
        if (n_in != 11 || ws_size < WS_END) { fprintf(stderr, "kernel_launch: unexpected inputs (n_in %d, ws %zu)\n", n_in, ws_size); grid = -1; return; }
        int dev = 0, cus = 0, per_cu = 0;
        (void)hipGetDevice(&dev); (void)hipDeviceGetAttribute(&cus, hipDeviceAttributeMultiprocessorCount, dev);
        (void)hipFuncSetAttribute((const void*)fwd_megakernel, hipFuncAttributeMaxDynamicSharedMemorySize, LDS_BYTES);
        if (hipOccupancyMaxActiveBlocksPerMultiprocessor(&per_cu, (const void*)fwd_megakernel, NWAVES * 64, LDS_BYTES) != hipSuccess || per_cu < 1) { fprintf(stderr, "kernel_launch: occupancy query says %d\n", per_cu); per_cu = 1; }
        (void)hipGetLastError();
        grid = cus;
        if (grid > 256) grid = 256;
    }
    if (grid < 0) return;
    (void)hipMemsetAsync((char*)d_ws + WS_CTL, 0, CTL_ZERO_BYTES, stream);
    Args a{};
    for (int i = 0; i < 11; ++i) a.in[i] = (const float*)d_in[i];
    a.out = (float*)d_out; a.ws = (unsigned char*)d_ws;
    void* kargs[] = {&a};
    hipError_t e = hipLaunchCooperativeKernel((const void*)fwd_megakernel, dim3(grid), dim3(NWAVES * 64), kargs, LDS_BYTES, stream);
    if (e != hipSuccess) fprintf(stderr, "cooperative launch failed: %s (grid %d)\n", hipGetErrorString(e), grid);
}
```

```cpp
#include <hip/hip_runtime.h>
#include <hip/hip_cooperative_groups.h>
#include <cstdio>
#include <cstdint>
namespace cg = cooperative_groups;
namespace pg8 {
#define PG8_LAS __attribute__((address_space(3)))
typedef unsigned short bf16_t;
typedef short bf16x8 __attribute__((ext_vector_type(8)));
typedef float f32x4 __attribute__((ext_vector_type(4)));
typedef unsigned u32x4 __attribute__((ext_vector_type(4)));
constexpr int BM = 256, BK = 64, HALF = 128, HTB = HALF * BK * 2  , STAGE_BYTES = 8 * HTB, NXCD = 8, WGM = 8;

__host__ __device__ __forceinline__ int lds_byte(int r, int c) { const int st = (r >> 4) * 2 + (c >> 5), rr = r & 15, cc = c & 31, ob = rr * 64 + cc * 2; return st * 1024 + (ob ^ (((ob >> 9) & 1) << 5)); }
__host__ __device__ __forceinline__ void stage_rc(int b, int& R, int& C) { const int st = b / 1024, sb = b % 1024, swz = sb ^ (((sb >> 9) & 1) << 5); R = (st >> 1) * 16 + swz / 64; C = (st & 1) * 32 + (swz % 64) / 2; }
__host__ __device__ __forceinline__ int perm32(int rho) { const int n = rho >> 4, i = rho & 15; return 8 * (i >> 2) + 4 * n + (i & 3); }

struct Unit { int pm, pn; };
struct Gemm { const bf16_t* A; const bf16_t* Bt; int M, N, K; };

struct StaticOrder {
    int nM, nN, nwg, G, c, rev;
    __host__ __device__ void init(int M, int N, int G_, int c_, int rev_ = 0) { nM = M / BM; nN = N / BM; nwg = nM * nN; G = G_; c = c_; rev = (rev_ && nwg % G_ == 0) ? nwg / G_ : 0; }
    __host__ __device__ bool next(int i, Unit& u) const {
        const long L = (long)(rev ? rev - 1 - i : i) * G + c; if (L >= nwg || L < 0) return false;
        int wgid = (int)L; { const int q = nwg / NXCD, r = nwg % NXCD, xcd = wgid % NXCD, off = wgid / NXCD; wgid = (xcd < r ? xcd * (q + 1) : r * (q + 1) + (xcd - r) * q) + off; }
        const int nig = WGM * nN, gid = wgid / nig, fm = gid * WGM, gsz = (nM - fm) < WGM ? (nM - fm) : WGM;
        u.pm = fm + ((wgid % nig) % gsz); u.pn = (wgid % nig) / gsz; return true;
    }
    __device__ __forceinline__ void a_ready(const Unit&) const {}
    __device__ __forceinline__ void done(const Unit&) const {}
};

__device__ __forceinline__ unsigned cvt_pk_bf16(float lo, float hi) { unsigned r; asm volatile("v_cvt_pk_bf16_f32 %0, %1, %2" : "=v"(r) : "v"(lo), "v"(hi)); return r; }
typedef float f32x2 __attribute__((ext_vector_type(2)));
typedef _Float16 f16x8 __attribute__((ext_vector_type(8)));
template <bool F16> __device__ __forceinline__ f32x4 mma16(bf16x8 a, bf16x8 b, f32x4 c) {
    if constexpr (F16) return __builtin_amdgcn_mfma_f32_16x16x32_f16(__builtin_bit_cast(f16x8, a), __builtin_bit_cast(f16x8, b), c, 0, 0, 0);
    else return __builtin_amdgcn_mfma_f32_16x16x32_bf16(a, b, c, 0, 0, 0);
}
__device__ __forceinline__ float ld_agent_f32(const float* p) { return __hip_atomic_load(p, __ATOMIC_RELAXED, __HIP_MEMORY_SCOPE_AGENT); }
typedef unsigned u32x2 __attribute__((ext_vector_type(2)));
__device__ __forceinline__ void row_stats8(const float* st, int row0, float (&mu)[2][4], float (&rs)[2][4]) {
#pragma unroll
    for (int ai = 0; ai < 2; ++ai)
#pragma unroll
        for (int m = 0; m < 4; ++m) { if (st) { const int row = row0 + ai * HALF + m * 16; const f32x2 sq = *(const f32x2*)(st + 2 * row);
            const float mm = sq[0] * (1.0f / 1024.0f), var = fmaxf(sq[1] * (1.0f / 1024.0f) - mm * mm, 0.f); mu[ai][m] = mm; rs[ai][m] = __builtin_amdgcn_rsqf(var + 1e-5f); } else { mu[ai][m] = 0.f; rs[ai][m] = 1.f; } }
}
__device__ __forceinline__ void stash_unit(const Unit& u, int wid, int lane, const float* cs, const float* bw, const float* stat, PG8_LAS float* st) {
    const float* src = (wid < 4 ? cs : bw) + u.pn * BM + (wid & 3) * 64 + lane;
    __builtin_amdgcn_global_load_lds((const unsigned*)src, (PG8_LAS unsigned*)(st + wid * 64), 4, 0, 0);
    __builtin_amdgcn_global_load_lds((const unsigned*)(stat + 2 * (size_t)(u.pm * BM) + wid * 64 + lane), (PG8_LAS unsigned*)(st + 512 + wid * 64), 4, 0, 0);
}
__device__ __forceinline__ void row_stats8_lds(const PG8_LAS float* st, int rl0, float (&mu)[2][4], float (&rs)[2][4]) {
#pragma unroll
    for (int ai = 0; ai < 2; ++ai)
#pragma unroll
        for (int m = 0; m < 4; ++m) { const f32x2 sq = *(const PG8_LAS f32x2*)(st + 512 + 2 * (rl0 + ai * HALF + m * 16));
            const float mm = sq[0] * (1.0f / 1024.0f), var = fmaxf(sq[1] * (1.0f / 1024.0f) - mm * mm, 0.f); mu[ai][m] = mm; rs[ai][m] = __builtin_amdgcn_rsqf(var + 1e-5f); }
}
struct EpiSwiglu {
    static constexpr bool PERM = true, AFTER_DRAIN = false, STASH = true;
    bf16_t* H; const float* stat; const float* cs; const float* bw; PG8_LAS float* st;
    __device__ __forceinline__ void stash(const Unit& u, int wid, int lane) const { stash_unit(u, wid, lane, cs, bw, stat, st); }
    __device__ __forceinline__ void operator()(const f32x4 (&acc)[2][2][4][2], const Unit& u, int wr, int wc, int fr, int fq) const {
        const int row0 = u.pm * BM + wr * 64 + fr; const int cc = u.pn * BM + wc * 32 + 8 * fq; const int hc = u.pn * HALF + wc * 32 + 8 * fq;
        float mu[2][4], rs[2][4]; row_stats8_lds(st, wr * 64 + fr, mu, rs);
        const int lc = wc * 32 + 8 * fq;
        f32x4 csg[2], csu[2], bwg[2], bwu[2];
#pragma unroll
        for (int n = 0; n < 2; ++n) { csg[n] = *(const PG8_LAS f32x4*)(st + lc + 4 * n); csu[n] = *(const PG8_LAS f32x4*)(st + lc + HALF + 4 * n); bwg[n] = *(const PG8_LAS f32x4*)(st + 256 + lc + 4 * n); bwu[n] = *(const PG8_LAS f32x4*)(st + 256 + lc + HALF + 4 * n); }
#pragma unroll
        for (int ai = 0; ai < 2; ++ai)
#pragma unroll
            for (int m = 0; m < 4; ++m) { const int row = row0 + ai * HALF + m * 16; f32x4 hv[2];
#pragma unroll
                for (int n = 0; n < 2; ++n) { const f32x4 g = (acc[ai][0][m][n] - csg[n] * mu[ai][m]) * rs[ai][m] + bwg[n], up = (acc[ai][1][m][n] - csu[n] * mu[ai][m]) * rs[ai][m] + bwu[n];
                    const f32x4 t = g * -1.4426950408889634f; f32x4 e = (f32x4){__builtin_amdgcn_exp2f(t[0]), __builtin_amdgcn_exp2f(t[1]), __builtin_amdgcn_exp2f(t[2]), __builtin_amdgcn_exp2f(t[3])};
                    e = e + 1.0f; const f32x4 r = (f32x4){__builtin_amdgcn_rcpf(e[0]), __builtin_amdgcn_rcpf(e[1]), __builtin_amdgcn_rcpf(e[2]), __builtin_amdgcn_rcpf(e[3])};
                    hv[n] = (g * up) * r; }
                u32x4 w; w.x = cvt_pk_bf16(hv[0][0], hv[0][1]); w.y = cvt_pk_bf16(hv[0][2], hv[0][3]); w.z = cvt_pk_bf16(hv[1][0], hv[1][1]); w.w = cvt_pk_bf16(hv[1][2], hv[1][3]);
                *(u32x4*)(H + (size_t)row * 2816 + hc) = w; }
    }
};
struct EpiQKV {
    static constexpr bool PERM = true, AFTER_DRAIN = false, STASH = true;
    bf16_t* Q; size_t tstride; const float* stat; const float* cs; const float* bw; float qscale; PG8_LAS float* st;
    __device__ __forceinline__ void stash(const Unit& u, int wid, int lane) const { stash_unit(u, wid, lane, cs, bw, stat, st); }
    __device__ __forceinline__ void operator()(const f32x4 (&acc)[2][2][4][2], const Unit& u, int wr, int wc, int fr, int fq) const {
        const int row0 = u.pm * BM + wr * 64 + fr; const int cc = u.pn * BM + wc * 32 + 8 * fq;
        const int t = (u.pn * BM) >> 10; bf16_t* base = Q + (size_t)t * tstride; const int col0 = ((u.pn * BM) & 1023) + wc * 32 + 8 * fq; const float sc = (t == 0) ? qscale : 1.0f;
        float mu[2][4], rs[2][4]; row_stats8_lds(st, wr * 64 + fr, mu, rs);
        const int lc = wc * 32 + 8 * fq;
#pragma unroll
        for (int bj = 0; bj < 2; ++bj) { const f32x4 cs0 = *(const PG8_LAS f32x4*)(st + lc + bj * HALF), cs1 = *(const PG8_LAS f32x4*)(st + lc + bj * HALF + 4), bw0 = *(const PG8_LAS f32x4*)(st + 256 + lc + bj * HALF), bw1 = *(const PG8_LAS f32x4*)(st + 256 + lc + bj * HALF + 4);
#pragma unroll
            for (int ai = 0; ai < 2; ++ai)
#pragma unroll
                for (int m = 0; m < 4; ++m) { const int row = row0 + ai * HALF + m * 16;
                    const f32x4 v0 = ((acc[ai][bj][m][0] - cs0 * mu[ai][m]) * rs[ai][m] + bw0) * sc, v1 = ((acc[ai][bj][m][1] - cs1 * mu[ai][m]) * rs[ai][m] + bw1) * sc;
                    u32x4 w; w.x = cvt_pk_bf16(v0[0], v0[1]); w.y = cvt_pk_bf16(v0[2], v0[3]); w.z = cvt_pk_bf16(v1[0], v1[1]); w.w = cvt_pk_bf16(v1[2], v1[3]);
                    *(u32x4*)(base + (size_t)row * 1024 + col0 + bj * HALF) = w; } }
    }
};
struct EpiResid {
    static constexpr bool PERM = true, AFTER_DRAIN = false, STASH = false;
    _Float16* z; const float* stat_in; const PG8_LAS float* gb; float* stat_out; float coef;
    __device__ __forceinline__ void operator()(const f32x4 (&acc)[2][2][4][2], const Unit& u, int wr, int wc, int fr, int fq) const {
        constexpr float ALPHA = 1.681792830507429f;
        const int row0 = u.pm * BM + wr * 64 + fr; const int col0 = u.pn * BM + wc * 32 + 8 * fq;
#pragma unroll
        for (int ai = 0; ai < 2; ++ai) {
            f32x2 sq[4]; f16x8 hh[4][2];
#pragma unroll
            for (int m = 0; m < 4; ++m) { sq[m] = *(const f32x2*)(stat_in + 2 * (row0 + ai * HALF + m * 16));
#pragma unroll
                for (int bj = 0; bj < 2; ++bj) hh[m][bj] = *(const f16x8*)(z + (unsigned)(row0 + ai * HALF + m * 16) * 1024u + (unsigned)col0 + bj * HALF); }
            float tprev = 0.f;
#pragma unroll
            for (int m = 0; m < 4; ++m) { const int row = row0 + ai * HALF + m * 16; const unsigned off = (unsigned)row * 1024u + (unsigned)col0;
                const f16x8 (&h)[2] = hh[m];
                const float mu = sq[m][0] * (1.0f / 1024.0f), var = fmaxf(sq[m][1] * (1.0f / 1024.0f) - mu * mu, 0.f), rs = __builtin_amdgcn_rsqf(var + 1e-5f);
                float s = 0.f, q = 0.f;
#pragma unroll
                for (int bj = 0; bj < 2; ++bj) { f32x4 zn[2];
#pragma unroll
                    for (int n = 0; n < 2; ++n) { const f32x4 zr = (f32x4){(float)h[bj][4 * n], (float)h[bj][4 * n + 1], (float)h[bj][4 * n + 2], (float)h[bj][4 * n + 3]};
                        const f32x4 gv = *(const PG8_LAS f32x4*)(gb + col0 + bj * HALF + 4 * n), bv = *(const PG8_LAS f32x4*)(gb + 1024 + col0 + bj * HALF + 4 * n);
                        const f32x4 xn = (zr - mu) * rs * gv + bv;
                        zn[n] = xn * ALPHA + acc[ai][bj][m][n] * coef;
                        s += (zn[n][0] + zn[n][1]) + (zn[n][2] + zn[n][3]); q += (zn[n][0] * zn[n][0] + zn[n][1] * zn[n][1]) + (zn[n][2] * zn[n][2] + zn[n][3] * zn[n][3]); }
                    const f16x8 w = (f16x8){(_Float16)zn[0][0], (_Float16)zn[0][1], (_Float16)zn[0][2], (_Float16)zn[0][3], (_Float16)zn[1][0], (_Float16)zn[1][1], (_Float16)zn[1][2], (_Float16)zn[1][3]};
                    *(f16x8*)(z + off + bj * HALF) = w; }
                const bool odd = (fq & 1) != 0; float t = odd ? q : s; const float u = odd ? s : q;
                t += __shfl_xor(u, 16); t += __shfl_xor(t, 32);
                if (m & 1) { const int arow = row0 + ai * HALF + (m - 1 + (fq >> 1)) * 16; unsafeAtomicAdd(stat_out + 2 * arow + (fq & 1), (fq >> 1) ? t : tprev); }
                tprev = t; }
            asm volatile("" ::: "memory"); }
    }
};

template <class Epi, class Sched, bool ALIGN_EPI = false, bool SP2 = false, bool F16 = false>
__device__ __forceinline__ void gemm_phase(PG8_LAS unsigned char* lds, const int tid, const Gemm g, const Sched& S, const Epi& E) {
    const int  wid = __builtin_amdgcn_readfirstlane(tid >> 6), lane = tid & 63, wr = wid >> 2, wc = wid & 3, fr = lane & 15, fq = lane >> 4;
    const int K = g.K, nt = K / BK;
    unsigned voffA[2], voffB[2];
#pragma unroll
    for (int i = 0; i < 2; ++i) { int R, C; stage_rc(tid * 16 + i * 8192, R, C); const int Rb = Epi::PERM ? ((R & ~31) + perm32(R & 31)) : R;
        voffA[i] = (unsigned)(R * K + C) * 2u; voffB[i] = (unsigned)(Rb * K + C) * 2u; }
    const size_t kstep = (size_t)(BK * 2);
    const size_t hstep = (size_t)HALF * K * 2;
    const size_t tstep = 2 * hstep;
    const unsigned ldsw = (unsigned)wid * 1024u;
    const int aoff = lds_byte(wr * 64 + fr, fq * 8), boff = lds_byte(wc * 32 + fr, fq * 8);
#define PG8_SA(b, h) (((b) * 2 + (h)) * HTB)
#define PG8_SB(b, h) ((4 + (b) * 2 + (h)) * HTB)
#define PG8_STAGE(bufoff, gbase, voff) do { _Pragma("unroll") for (int _i = 0; _i < 2; ++_i) \
        __builtin_amdgcn_global_load_lds((const unsigned*)((const char*)(gbase) + (voff)[_i]), (PG8_LAS unsigned*)(lds + (bufoff) + ldsw + _i * 8192), 16, 0, 0); } while (0)
#define PG8_LDA(dst, b, h) do { _Pragma("unroll") for (int m = 0; m < 4; ++m) _Pragma("unroll") for (int k = 0; k < 2; ++k) dst[m][k] = *(const PG8_LAS bf16x8*)(lds + PG8_SA(b, h) + aoff + m * 2048 + k * 1024); } while (0)
#define PG8_LDB(dst, b, h) do { _Pragma("unroll") for (int n = 0; n < 2; ++n) _Pragma("unroll") for (int k = 0; k < 2; ++k) dst[n][k] = *(const PG8_LAS bf16x8*)(lds + PG8_SB(b, h) + boff + n * 2048 + k * 1024); } while (0)
#define PG8_MMA(ai, bj, At, Bt) do { __builtin_amdgcn_s_setprio(1); _Pragma("unroll") for (int m = 0; m < 4; ++m) _Pragma("unroll") for (int n = 0; n < 2; ++n) _Pragma("unroll") for (int k = 0; k < 2; ++k) \
        acc[ai][bj][m][n] = mma16<F16>(Bt[n][k], At[m][k], acc[ai][bj][m][n]); __builtin_amdgcn_s_setprio(0); } while (0)
#define PG8_WAIT_V(n) asm volatile("s_waitcnt vmcnt(" #n ")" ::: "memory")
#define PG8_WAIT_L(n) asm volatile("s_waitcnt lgkmcnt(" #n ")" ::: "memory")
#define PG8_BAR __builtin_amdgcn_s_barrier()
#define PG8_SCHED __builtin_amdgcn_sched_barrier(0)
    Unit cur, nxt; int ui = 0;
    if (!S.next(0, cur)) return;
    f32x4 acc[2][2][4][2];
#pragma unroll
    for (int a = 0; a < 2; ++a)
#pragma unroll
        for (int b = 0; b < 2; ++b)
#pragma unroll
            for (int m = 0; m < 4; ++m)
#pragma unroll
                for (int n = 0; n < 2; ++n) acc[a][b][m][n] = (f32x4){0.f, 0.f, 0.f, 0.f};
    bf16x8 At[4][2], B0[2][2], B1[2][2];
    const char* cA = (const char*)g.A + (size_t)cur.pm * tstep; const char* cB = (const char*)g.Bt + (size_t)cur.pn * tstep;
    S.a_ready(cur);
    if constexpr (SP2) {
        PG8_STAGE(PG8_SB(0, 0), cB, voffB); PG8_STAGE(PG8_SB(0, 1), cB + hstep, voffB); PG8_STAGE(PG8_SA(0, 0), cA, voffA); PG8_STAGE(PG8_SA(0, 1), cA + hstep, voffA);
        if (wr == 1) PG8_BAR;
        PG8_WAIT_V(2); PG8_BAR;
        PG8_STAGE(PG8_SB(1, 0), cB + kstep, voffB); PG8_STAGE(PG8_SA(1, 0), cA + kstep, voffA); PG8_STAGE(PG8_SB(1, 1), cB + hstep + kstep, voffB);
        PG8_WAIT_V(6); PG8_BAR;
    } else {
        PG8_STAGE(PG8_SB(0, 0), cB, voffB); PG8_STAGE(PG8_SA(0, 0), cA, voffA); PG8_STAGE(PG8_SB(0, 1), cB + hstep, voffB); PG8_STAGE(PG8_SA(0, 1), cA + hstep, voffA);
        if (wr == 1) PG8_BAR;
        PG8_WAIT_V(4); PG8_BAR;
        PG8_STAGE(PG8_SB(1, 0), cB + kstep, voffB); PG8_STAGE(PG8_SA(1, 0), cA + kstep, voffA); PG8_STAGE(PG8_SB(1, 1), cB + hstep + kstep, voffB);
        PG8_WAIT_V(6); PG8_BAR;
    }
    for (;;) {
        const bool has_next = S.next(ui + 1, nxt);
        const char* nA = has_next ? (const char*)g.A + (size_t)nxt.pm * tstep : cA; const char* nB = has_next ? (const char*)g.Bt + (size_t)nxt.pn * tstep : cB;
        for (int t = 0; t < nt; t += 2) {
            const bool last = (t == nt - 2);
            const char* a1 = cA + (size_t)(t + 1) * kstep;
            const char* a2 = last ? nA : cA + (size_t)(t + 2) * kstep; const char* b2 = last ? nB : cB + (size_t)(t + 2) * kstep;
            const char* a3 = a2 + kstep; const char* b3 = b2 + kstep;
            if (last && has_next) S.a_ready(nxt);
            if constexpr (Epi::STASH) { if (last) E.stash(cur, wid, lane); }
            if constexpr (SP2) {
            PG8_LDB(B0, 0, 0); PG8_LDB(B1, 0, 1); PG8_SCHED; PG8_LDA(At, 0, 0); PG8_STAGE(PG8_SA(1, 1), a1 + hstep, voffA);
            PG8_WAIT_V(8); PG8_WAIT_L(0); PG8_BAR; PG8_MMA(0, 0, At, B0); PG8_MMA(0, 1, At, B1); PG8_BAR; PG8_SCHED;
            PG8_LDA(At, 0, 1); PG8_STAGE(PG8_SB(0, 0), b2, voffB); PG8_STAGE(PG8_SB(0, 1), b2 + hstep, voffB); PG8_STAGE(PG8_SA(0, 0), a2, voffA);
            PG8_WAIT_V(8); PG8_WAIT_L(0); PG8_BAR; PG8_MMA(1, 0, At, B0); PG8_MMA(1, 1, At, B1); PG8_BAR; PG8_SCHED;
            PG8_LDB(B0, 1, 0); PG8_LDB(B1, 1, 1); PG8_SCHED; PG8_LDA(At, 1, 0); PG8_STAGE(PG8_SA(0, 1), a2 + hstep, voffA);
            PG8_WAIT_V(8); PG8_WAIT_L(0); PG8_BAR; PG8_MMA(0, 0, At, B0); PG8_MMA(0, 1, At, B1); PG8_BAR; PG8_SCHED;
            PG8_LDA(At, 1, 1); PG8_STAGE(PG8_SB(1, 0), b3, voffB); PG8_STAGE(PG8_SB(1, 1), b3 + hstep, voffB); PG8_STAGE(PG8_SA(1, 0), a3, voffA);
            PG8_WAIT_V(8); PG8_WAIT_L(0); PG8_BAR; PG8_MMA(1, 0, At, B0); PG8_MMA(1, 1, At, B1); PG8_BAR; PG8_SCHED;
            } else {
            PG8_LDB(B0, 0, 0); PG8_SCHED; PG8_LDA(At, 0, 0); PG8_STAGE(PG8_SA(1, 1), a1 + hstep, voffA);
            PG8_WAIT_L(8); PG8_BAR; PG8_WAIT_L(0); PG8_MMA(0, 0, At, B0); PG8_BAR; PG8_SCHED;
            PG8_LDB(B1, 0, 1); PG8_STAGE(PG8_SB(0, 0), b2, voffB);
            PG8_BAR; PG8_WAIT_L(0); PG8_MMA(0, 1, At, B1); PG8_BAR;
            PG8_LDA(At, 0, 1); PG8_STAGE(PG8_SA(0, 0), a2, voffA);
            PG8_BAR; PG8_WAIT_L(0); PG8_MMA(1, 0, At, B0); PG8_BAR; PG8_SCHED;
            PG8_STAGE(PG8_SB(0, 1), b2 + hstep, voffB);
            PG8_WAIT_V(6); PG8_BAR; PG8_MMA(1, 1, At, B1); PG8_BAR;
            PG8_LDB(B0, 1, 0); PG8_SCHED; PG8_LDA(At, 1, 0); PG8_STAGE(PG8_SA(0, 1), a2 + hstep, voffA);
            PG8_WAIT_L(8); PG8_BAR; PG8_WAIT_L(0); PG8_MMA(0, 0, At, B0); PG8_BAR; PG8_SCHED;
            PG8_LDB(B1, 1, 1); PG8_STAGE(PG8_SB(1, 0), b3, voffB);
            PG8_BAR; PG8_WAIT_L(0); PG8_MMA(0, 1, At, B1); PG8_BAR;
            PG8_LDA(At, 1, 1); PG8_STAGE(PG8_SA(1, 0), a3, voffA);
            PG8_BAR; PG8_WAIT_L(0); PG8_MMA(1, 0, At, B0); PG8_BAR; PG8_SCHED;
            PG8_STAGE(PG8_SB(1, 1), b3 + hstep, voffB);
            PG8_WAIT_V(6); PG8_BAR; PG8_MMA(1, 1, At, B1); PG8_BAR;
            }
        }
        if constexpr (ALIGN_EPI) { if (wr == 0) PG8_BAR; }
        if constexpr (!Epi::AFTER_DRAIN) { E(acc, cur, wr, wc, fr, fq); S.done(cur); }
        if (!has_next) break;
#pragma unroll
        for (int a = 0; a < 2; ++a)
#pragma unroll
            for (int b = 0; b < 2; ++b)
#pragma unroll
                for (int m = 0; m < 4; ++m)
#pragma unroll
                    for (int n = 0; n < 2; ++n) acc[a][b][m][n] = (f32x4){0.f, 0.f, 0.f, 0.f};
        cur = nxt; cA = nA; cB = nB; ++ui;
        if constexpr (ALIGN_EPI) { if (wr == 1) PG8_BAR; }
    }
    PG8_WAIT_V(0);
    if constexpr (!ALIGN_EPI) { if (wr == 0) PG8_BAR; }
    PG8_BAR;
    if constexpr (Epi::AFTER_DRAIN) { E.fused(acc, cur, wr, wc, fr, fq, lds, wid, lane); S.done(cur); }
#undef PG8_SA
#undef PG8_SB
#undef PG8_STAGE
#undef PG8_LDA
#undef PG8_LDB
#undef PG8_MMA
#undef PG8_WAIT_V
#undef PG8_WAIT_L
#undef PG8_BAR
#undef PG8_SCHED
}
}
namespace att {
#define ALAS __attribute__((address_space(3)))
typedef unsigned short bf16_t;
typedef short bf16x8 __attribute__((ext_vector_type(8)));
typedef short s16x4 __attribute__((ext_vector_type(4)));
typedef float f32x16 __attribute__((ext_vector_type(16)));
typedef unsigned u32x4 __attribute__((ext_vector_type(4)));
constexpr int DM = 1024, SEQ = 2048;
constexpr int VHALF = 4096;
constexpr int L_KV = 0;
constexpr int L_WSF = 65536;
constexpr int L_TAB = 65536 + 2048;
constexpr int L_OST = 65536 + 8192;
constexpr int L_FLAG = L_OST + 32768;
constexpr float LOG2E = 1.4426950408889634f;
__device__ __forceinline__ int crow(int r, int hi) { return (r & 3) + 8 * (r >> 2) + 4 * hi; }
__device__ __forceinline__ unsigned cvtpk(float lo, float hi) { unsigned r; asm volatile("v_cvt_pk_bf16_f32 %0, %1, %2" : "=v"(r) : "v"(lo), "v"(hi)); return r; }
typedef short v4i16_t __attribute__((ext_vector_type(4)));
__device__ __forceinline__ s16x4 vtr(const ALAS unsigned char* p) { return __builtin_bit_cast(s16x4, __builtin_amdgcn_ds_read_tr16_b64_v4i16((ALAS v4i16_t*)p)); }

struct Stage { u32x4 k[2], v[2]; };
__device__ __forceinline__ void stage_load(Stage& s, const bf16_t* Kg, const bf16_t* Vg, long tok0, int hcol, int t256) {
#pragma unroll
    for (int i = 0; i < 2; ++i) { const int cid = t256 + 256 * i, row = cid >> 3, ch = cid & 7; const size_t o = (size_t)(tok0 + row) * DM + hcol + ch * 8;
        s.k[i] = *(const u32x4*)(Kg + o); s.v[i] = *(const u32x4*)(Vg + o); }
}
__device__ __forceinline__ void stage_store(const Stage& s, ALAS unsigned char* kbuf, ALAS unsigned char* vbuf, int t256) {
#pragma unroll
    for (int i = 0; i < 2; ++i) { const int cid = t256 + 256 * i, row = cid >> 3, ch = cid & 7;
        *(ALAS u32x4*)(kbuf + row * 128 + ((ch ^ ((row >> 1) & 7)) << 4)) = s.k[i];
        *(ALAS u32x4*)(vbuf + (ch >> 2) * VHALF + row * 64 + (ch & 3) * 16) = s.v[i]; }
}
__device__ __forceinline__ void qk_tile(f32x16& p0, f32x16& p1, const ALAS unsigned char* kbuf, const bf16x8 (&qr)[4], int r32, int hi, const f32x16& cinit) {
    const int sw = (r32 >> 1) & 7;
#pragma unroll
    for (int d0 = 0; d0 < 4; ++d0) { const int ch = 2 * d0 + hi;
        const bf16x8 a0 = *(const ALAS bf16x8*)(kbuf + r32 * 128 + ((ch ^ sw) << 4));
        const bf16x8 a1 = *(const ALAS bf16x8*)(kbuf + (r32 + 32) * 128 + ((ch ^ sw) << 4));
        p0 = __builtin_amdgcn_mfma_f32_32x32x16_bf16(a0, qr[d0], d0 == 0 ? cinit : p0, 0, 0, 0);
        p1 = __builtin_amdgcn_mfma_f32_32x32x16_bf16(a1, qr[d0], d0 == 0 ? cinit : p1, 0, 0, 0); }
}
__device__ __forceinline__ float max3f(float a, float b, float c) { float r; asm("v_max3_f32 %0, %1, %2, %3" : "=v"(r) : "v"(a), "v"(b), "v"(c)); return r; }
__device__ __forceinline__ void pv_tile(f32x16 (&o)[2], const ALAS unsigned char* vbuf, const f32x16& p0, const f32x16& p1, int lane, int hi) {
    u32x4 pw[4];
#pragma unroll
    for (int k = 0; k < 2; ++k) { pw[k] = (u32x4){cvtpk(p0[8 * k + 0], p0[8 * k + 1]), cvtpk(p0[8 * k + 2], p0[8 * k + 3]), cvtpk(p0[8 * k + 4], p0[8 * k + 5]), cvtpk(p0[8 * k + 6], p0[8 * k + 7])};
        pw[2 + k] = (u32x4){cvtpk(p1[8 * k + 0], p1[8 * k + 1]), cvtpk(p1[8 * k + 2], p1[8 * k + 3]), cvtpk(p1[8 * k + 4], p1[8 * k + 5]), cvtpk(p1[8 * k + 6], p1[8 * k + 7])}; }
    const ALAS unsigned char* vp = vbuf + ((lane >> 4) & 1) * 32 + (lane & 3) * 8 + (4 * hi + ((lane & 15) >> 2)) * 64;
#pragma unroll
    for (int d0 = 0; d0 < 2; ++d0)
#pragma unroll
        for (int ks = 0; ks < 4; ++ks) { const s16x4 lo = vtr(vp + d0 * VHALF + ks * 1024), hh = vtr(vp + d0 * VHALF + ks * 1024 + 512);
            const bf16x8 vb = (bf16x8){lo[0], lo[1], lo[2], lo[3], hh[0], hh[1], hh[2], hh[3]};
            o[d0] = __builtin_amdgcn_mfma_f32_32x32x16_bf16(__builtin_bit_cast(bf16x8, pw[ks]), vb, o[d0], 0, 0, 0); }
}
__device__ __forceinline__ void store_o(const f32x16 (&o)[2], ALAS unsigned char* lds, int wid, int lane, int r32, int hi, bf16_t* Og  , bool scaled) {
    ALAS float* wsf = (ALAS float*)(lds + L_WSF) + wid * 64;
    ALAS bf16_t* stg = (ALAS bf16_t*)(lds + L_OST) + wid * 2048;
#pragma unroll
    for (int r = 0; r < 16; ++r) { const int orow = crow(r, hi); const float sc = scaled ? wsf[orow] : 1.0f;
#pragma unroll
        for (int d0 = 0; d0 < 2; ++d0) { const unsigned w = cvtpk(o[d0][r] * sc, 0.f); stg[orow * 64 + d0 * 32 + r32] = (bf16_t)(w & 0xffffu); } }
    asm volatile("s_waitcnt lgkmcnt(0)" ::: "memory");
#pragma unroll
    for (int i = 0; i < 4; ++i) { const int row = i * 8 + (lane >> 3), ch = lane & 7; const u32x4 v = *(const ALAS u32x4*)(stg + row * 64 + ch * 8); *(u32x4*)(Og + (size_t)row * DM + ch * 8) = v; }
    asm volatile("s_waitcnt lgkmcnt(0)" ::: "memory");
}

__device__ __forceinline__ void chunk_prefetch(int b, int hp, int qblk, const bf16_t* Q, const bf16_t* K, const bf16_t* V, bf16x8 (&qn)[4], Stage& Sn, const int tid) {
    const int lane = tid & 63, r32 = lane & 31, hi = lane >> 5, wid = __builtin_amdgcn_readfirstlane(tid >> 6), half = wid >> 2, w4 = half ? 3 - (wid & 3) : (wid & 3), t256 = tid & 255;
    const int hcol = (2 * hp + half) * 64; const long tokb = (long)b * SEQ;
    const int cq = 2 * qblk + (w4 >> 1), tq0 = cq * 64 + (w4 & 1) * 32, kc_lo = (2 * qblk - 8) > 0 ? (2 * qblk - 8) : 0;
#pragma unroll
    for (int d0 = 0; d0 < 4; ++d0) qn[d0] = *(const bf16x8*)(Q + (size_t)(tokb + tq0 + r32) * DM + hcol + d0 * 16 + hi * 8);
    stage_load(Sn, K, V, tokb + (long)kc_lo * 64, hcol, t256);
}
__device__ __forceinline__ void chunk_attn_unit(int b, int hp, int qblk, int qblk_next, bf16x8 (&qn)[4], Stage& Sn, const bf16_t* Q, const bf16_t* K, const bf16_t* V, bf16_t* O, const float* rel, ALAS unsigned char* lds, const int tid) {
    const int lane = tid & 63, r32 = lane & 31, hi = lane >> 5, wid = __builtin_amdgcn_readfirstlane(tid >> 6), half = wid >> 2, w4 = half ? 3 - (wid & 3) : (wid & 3), t256 = tid & 255;
    const int h = 2 * hp + half, hcol = h * 64; const long tokb = (long)b * SEQ;
    const int cq = 2 * qblk + (w4 >> 1), iq0 = (w4 & 1) * 32, tq0 = cq * 64 + iq0;
    ALAS float* wsf = (ALAS float*)(lds + L_WSF) + wid * 64;
    ALAS float* tab = (ALAS float*)(lds + L_TAB) + half * 260;
    bf16x8 qr[4];
#pragma unroll
    for (int d0 = 0; d0 < 4; ++d0) qr[d0] = qn[d0];
    for (int i = t256; i < 257; i += 256) tab[i] = rel[i * 16 + h] * LOG2E;
    const int kc_lo = (2 * qblk - 8) > 0 ? (2 * qblk - 8) : 0, n = 2 * qblk + 1 - kc_lo + 1;
    Stage S0 = Sn, S1;
    stage_store(S0, lds + L_KV + ((0 * 2 + half) * 2 + 0) * 8192, lds + L_KV + ((0 * 2 + half) * 2 + 1) * 8192, t256);
    if (n > 1) stage_load(S0, K, V, tokb + (long)(kc_lo + 1) * 64, hcol, t256);
    if (n > 2) stage_load(S1, K, V, tokb + (long)(kc_lo + 2) * 64, hcol, t256);
    __syncthreads();
    float mrun = -INFINITY, lrun = 0.f; f32x16 o[2]; o[0] = (f32x16){}; o[1] = (f32x16){};
    const f32x16 zero16 = {}; f32x16 bcv; { const float bc = tab[256];
#pragma unroll
        for (int r = 0; r < 16; ++r) bcv[r] = bc; }
    auto compute = [&](const int i, const int bufc) __attribute__((always_inline)) { const int kc = kc_lo + i;
        if (kc >= cq - 8 && kc <= cq) {
            const ALAS unsigned char* kbuf = lds + L_KV + ((bufc * 2 + half) * 2 + 0) * 8192; const ALAS unsigned char* vbuf = kbuf + 8192;
            f32x16 p0, p1;
            const int delta = cq - kc;
            if (delta >= 3) qk_tile(p0, p1, kbuf, qr, r32, hi, bcv);
            else { qk_tile(p0, p1, kbuf, qr, r32, hi, zero16);
                const int base = delta * 64 + iq0 + r32 + 128;
#pragma unroll
                for (int r = 0; r < 16; ++r) { const int i0 = base - crow(r, hi), i1 = i0 - 32; p0[r] += tab[i0 > 256 ? 256 : i0]; p1[r] += tab[i1 > 256 ? 256 : i1]; } }
            float mx = max3f(p0[0], p1[0], p0[1]);
#pragma unroll
            for (int r = 1; r < 15; ++r) mx = max3f(mx, p1[r], p0[r + 1]);
            mx = fmaxf(mx, p1[15]);
            mx = fmaxf(mx, __shfl_xor(mx, 32));
            const float mn = fmaxf(mrun, mx), f = __builtin_amdgcn_exp2f(mrun - mn); mrun = mn;
#pragma unroll
            for (int r = 0; r < 16; ++r) { p0[r] = __builtin_amdgcn_exp2f(p0[r] - mn); p1[r] = __builtin_amdgcn_exp2f(p1[r] - mn); }
            const f32x16 ps = p0 + p1;
            float rs = ((ps[0] + ps[1]) + (ps[2] + ps[3])) + ((ps[4] + ps[5]) + (ps[6] + ps[7])) + (((ps[8] + ps[9]) + (ps[10] + ps[11])) + ((ps[12] + ps[13]) + (ps[14] + ps[15])));
            rs += __shfl_xor(rs, 32);
            lrun = lrun * f + rs;
            if (__any(f != 1.0f)) { if (hi == 0) wsf[r32] = f; asm volatile("s_waitcnt lgkmcnt(0)" ::: "memory");
#pragma unroll
                for (int r = 0; r < 16; ++r) { const float ff = wsf[crow(r, hi)]; o[0][r] *= ff; o[1][r] *= ff; }
                asm volatile("s_waitcnt lgkmcnt(0)" ::: "memory"); }
            pv_tile(o, vbuf, p0, p1, lane, hi);
        }
    };
#define ATT_STEP(ii, bufc, SX) do { compute((ii), (bufc)); \
        if ((ii) + 1 < n) stage_store(SX, lds + L_KV + ((((bufc) ^ 1) * 2 + half) * 2 + 0) * 8192, lds + L_KV + ((((bufc) ^ 1) * 2 + half) * 2 + 1) * 8192, t256); \
        if ((ii) + 3 < n) stage_load(SX, K, V, tokb + (long)(kc_lo + (ii) + 3) * 64, hcol, t256); \
        __syncthreads(); } while (0)
    for (int i = 0; i < n; i += 2) { ATT_STEP(i, 0, S0); if (i + 1 < n) ATT_STEP(i + 1, 1, S1); }
#undef ATT_STEP
    if (qblk_next >= 0) chunk_prefetch(b, hp, qblk_next, Q, K, V, qn, Sn, tid);
    if (hi == 0) wsf[r32] = 1.0f / lrun;
    asm volatile("s_waitcnt lgkmcnt(0)" ::: "memory");
    store_o(o, lds, wid, lane, r32, hi, O + (size_t)(tokb + tq0) * DM + hcol, true);
}

__device__ __forceinline__ void stick_prefetch(int b, int hp, int qb, const bf16_t* Q, const bf16_t* K, const bf16_t* V, bf16x8 (&qn)[4], Stage& Sn, const int tid) {
    const int lane = tid & 63, r32 = lane & 31, hi = lane >> 5, wid = __builtin_amdgcn_readfirstlane(tid >> 6), half = wid >> 2, w4 = half ? 3 - (wid & 3) : (wid & 3), t256 = tid & 255;
    const int hcol = (2 * hp + half) * 64; const long tokb = (long)b * SEQ; const int tq = qb * 128 + w4 * 32 + r32, n = 2 * qb + 2;
#pragma unroll
    for (int d0 = 0; d0 < 4; ++d0) qn[d0] = *(const bf16x8*)(Q + (size_t)(tokb + tq) * DM + hcol + d0 * 16 + hi * 8);
    stage_load(Sn, K, V, tokb + (long)(n - 1) * 64, hcol, t256);
}
__device__ __forceinline__ void stick_attn_unit(int b, int hp, int qb, int qb_next, bf16x8 (&qn)[4], Stage& Sn, const bf16_t* Q, const bf16_t* K, const bf16_t* V, bf16_t* O, ALAS unsigned char* lds, const int tid) {
    const int lane = tid & 63, r32 = lane & 31, hi = lane >> 5, wid = __builtin_amdgcn_readfirstlane(tid >> 6), half = wid >> 2, w4 = half ? 3 - (wid & 3) : (wid & 3), t256 = tid & 255;
    const int h = 2 * hp + half, hcol = h * 64; const long tokb = (long)b * SEQ;
    const int tq0 = qb * 128 + w4 * 32, tq = tq0 + r32;
    ALAS unsigned* flg = (ALAS unsigned*)(lds + L_FLAG);
    bf16x8 qr[4];
#pragma unroll
    for (int d0 = 0; d0 < 4; ++d0) qr[d0] = qn[d0];
    const int n = 2 * qb + 2;
    Stage S0 = Sn, S1;
    stage_store(S0, lds + L_KV + ((0 * 2 + half) * 2 + 0) * 8192, lds + L_KV + ((0 * 2 + half) * 2 + 1) * 8192, t256);
    stage_load(S0, K, V, tokb + (long)(n - 2) * 64, hcol, t256);
    if (n > 2) stage_load(S1, K, V, tokb + (long)(n - 3) * 64, hcol, t256);
    __syncthreads();
    float carry = 0.f; f32x16 o[2]; o[0] = (f32x16){}; o[1] = (f32x16){}; bool wdone = false;
    auto compute = [&](const int i, const int bufc) __attribute__((always_inline)) { const int kt = n - 1 - i, k0 = kt * 64;
        if (k0 < tq0 + 31 && !wdone) {
            const ALAS unsigned char* kbuf = lds + L_KV + ((bufc * 2 + half) * 2 + 0) * 8192; const ALAS unsigned char* vbuf = kbuf + 8192;
            f32x16 p0, p1; { const f32x16 zero16 = {}; qk_tile(p0, p1, kbuf, qr, r32, hi, zero16); }
            const bool needmask = (k0 + 63 >= tq0);
            f32x16 L0, L1;
#pragma unroll
            for (int r = 0; r < 16; ++r) {
                { const float zz = p0[r], e = __builtin_amdgcn_exp2f(-fabsf(zz)), lsp = __builtin_amdgcn_logf(1.0f + e); float lb = fminf(zz, 0.f) - lsp, l1 = lb - zz;
                  if (needmask && (k0 + crow(r, hi) >= tq)) { lb = -INFINITY; l1 = 0.f; } p0[r] = lb; L0[r] = l1; }
                { const float zz = p1[r], e = __builtin_amdgcn_exp2f(-fabsf(zz)), lsp = __builtin_amdgcn_logf(1.0f + e); float lb = fminf(zz, 0.f) - lsp, l1 = lb - zz;
                  if (needmask && (k0 + 32 + crow(r, hi) >= tq)) { lb = -INFINITY; l1 = 0.f; } p1[r] = lb; L1[r] = l1; }
            }
            float g0[4], g1[4], pg0[4], pg1[4];
#pragma unroll
            for (int g = 0; g < 4; ++g) { g0[g] = (L0[4 * g] + L0[4 * g + 1]) + (L0[4 * g + 2] + L0[4 * g + 3]); g1[g] = (L1[4 * g] + L1[4 * g + 1]) + (L1[4 * g + 2] + L1[4 * g + 3]); }
#pragma unroll
            for (int g = 0; g < 4; ++g) { pg0[g] = __shfl_xor(g0[g], 32); pg1[g] = __shfl_xor(g1[g], 32); }
            float suff = 0.f;
#pragma unroll
            for (int g = 3; g >= 0; --g) { const float e3 = carry + suff + (hi == 0 ? pg1[g] : 0.f), e2 = e3 + L1[4 * g + 3], e1 = e2 + L1[4 * g + 2], e0 = e1 + L1[4 * g + 1];
                p1[4 * g + 3] = __builtin_amdgcn_exp2f(p1[4 * g + 3] + e3); p1[4 * g + 2] = __builtin_amdgcn_exp2f(p1[4 * g + 2] + e2);
                p1[4 * g + 1] = __builtin_amdgcn_exp2f(p1[4 * g + 1] + e1); p1[4 * g + 0] = __builtin_amdgcn_exp2f(p1[4 * g + 0] + e0);
                suff += g1[g] + pg1[g]; }
            carry += suff; suff = 0.f;
#pragma unroll
            for (int g = 3; g >= 0; --g) { const float e3 = carry + suff + (hi == 0 ? pg0[g] : 0.f), e2 = e3 + L0[4 * g + 3], e1 = e2 + L0[4 * g + 2], e0 = e1 + L0[4 * g + 1];
                p0[4 * g + 3] = __builtin_amdgcn_exp2f(p0[4 * g + 3] + e3); p0[4 * g + 2] = __builtin_amdgcn_exp2f(p0[4 * g + 2] + e2);
                p0[4 * g + 1] = __builtin_amdgcn_exp2f(p0[4 * g + 1] + e1); p0[4 * g + 0] = __builtin_amdgcn_exp2f(p0[4 * g + 0] + e0);
                suff += g0[g] + pg0[g]; }
            carry += suff;
            pv_tile(o, vbuf, p0, p1, lane, hi);
        }
    };
    bool stop = false;
#define ATT_STEP(ii, bufc, SX) do { compute((ii), (bufc)); \
        { const int alld = __all(carry < -150.0f); wdone = alld != 0; if (lane == 0) flg[(bufc) * 8 + wid] = (unsigned)alld; } \
        if ((ii) + 1 < n) stage_store(SX, lds + L_KV + ((((bufc) ^ 1) * 2 + half) * 2 + 0) * 8192, lds + L_KV + ((((bufc) ^ 1) * 2 + half) * 2 + 1) * 8192, t256); \
        if ((ii) + 3 < n) stage_load(SX, K, V, tokb + (long)(n - 1 - ((ii) + 3)) * 64, hcol, t256); \
        __syncthreads(); \
        { const ALAS u32x4* fp = (const ALAS u32x4*)(flg + (bufc) * 8); const u32x4 f0 = fp[0], f1 = fp[1]; \
          stop = (f0[0] & f0[1] & f0[2] & f0[3] & f1[0] & f1[1] & f1[2] & f1[3]) != 0u; } } while (0)
    for (int i = 0; i < n; i += 2) { ATT_STEP(i, 0, S0); if (stop) break; if (i + 1 < n) { ATT_STEP(i + 1, 1, S1); if (stop) break; } }
#undef ATT_STEP
    if (qb_next >= 0) stick_prefetch(b, hp, qb_next, Q, K, V, qn, Sn, tid);
    store_o(o, lds, wid, lane, r32, hi, O + (size_t)(tokb + tq0) * DM + hcol, false);
}
#undef ALAS
}

#define GAS __attribute__((address_space(1)))
#define LAS __attribute__((address_space(3)))
typedef unsigned short bf16;
typedef unsigned v4u __attribute__((ext_vector_type(4)));
typedef float f32x4 __attribute__((ext_vector_type(4)));
typedef short bf16x8 __attribute__((ext_vector_type(8)));
typedef GAS unsigned gu32;
typedef GAS unsigned long long gu64;
#define RLX_AGENT __ATOMIC_RELAXED, __HIP_MEMORY_SCOPE_AGENT
#define LDS_WAIT() asm volatile("s_waitcnt lgkmcnt(0)" ::: "memory")
#define VM_WAIT() asm volatile("s_waitcnt vmcnt(0)" ::: "memory")
__device__ __forceinline__ unsigned long long rt() { return __builtin_amdgcn_s_memrealtime(); }
__device__ __forceinline__ unsigned f2bf(float f) { unsigned u = __builtin_bit_cast(unsigned, f); return (u + 0x7fffu + ((u >> 16) & 1u)) >> 16; }
__device__ __forceinline__ unsigned pk2(float lo, float hi) { return f2bf(lo) | (f2bf(hi) << 16); }

#define XB_TMO      128
#define XB_XCNT(j)  (256  + 64 * (j))
#define XB_XSUB(j)  (1280 + 64 * (j))
#define XB_XGEN(j)  (2304 + 64 * (j))
#define XB_TOP      3328
#define XB_TOPGEN   3392
#define XCD_BAR_WORDS 3456
#define XB_SPIN_CAP (1u << 18)

__device__ __forceinline__ unsigned xb_ld(unsigned* p)              { return __hip_atomic_load(p, __ATOMIC_RELAXED, __HIP_MEMORY_SCOPE_AGENT); }
__device__ __forceinline__ unsigned xb_add(unsigned* p, unsigned v) { return __hip_atomic_fetch_add(p, v, __ATOMIC_RELAXED, __HIP_MEMORY_SCOPE_AGENT); }
__device__ __forceinline__ unsigned xb_xcc_id() { return (unsigned)__builtin_amdgcn_s_getreg((3 << 11) | 20) & 0xFu; }
#define XB_SPIN(cond, bar) do { unsigned _sp = 0; while (cond) { __builtin_amdgcn_s_sleep(1); \
    if ((++_sp & 255u) == 0u) { if (xb_ld(&(bar)[XB_TMO])) break; if (_sp > XB_SPIN_CAP) { atomicAdd(&(bar)[XB_TMO], 1u); break; } } } } while (0)

struct XcdBarrier {
    unsigned* bar; unsigned x;
    volatile LAS unsigned* st;
};

__device__ __forceinline__ XcdBarrier xcd_barrier_post(unsigned* bar, volatile LAS unsigned* st) {
    XcdBarrier b; b.bar = bar; b.x = xb_xcc_id(); b.st = st;
    if (threadIdx.x == 0) (void)xb_add(&bar[XB_XCNT(b.x)], 1u);
    return b;
}
__device__ __forceinline__ void xcd_barrier_complete(unsigned* bar, unsigned x, unsigned& nloc, unsigned& nx) {
    const unsigned G = gridDim.x * gridDim.y * gridDim.z;
    unsigned sum, cnt, mine, sp = 0u;
    for (;;) {
        sum = 0u; cnt = 0u; mine = 0u;
#pragma unroll
        for (unsigned j = 0; j < 16; ++j) { const unsigned c = xb_ld(&bar[XB_XCNT(j)]); sum += c; cnt += (c > 0u) ? 1u : 0u; mine = (j == x) ? c : mine; }
        if (sum == G) break;
        __builtin_amdgcn_s_sleep(1);
        if ((++sp & 255u) == 0u) { if (xb_ld(&bar[XB_TMO])) break; if (sp > XB_SPIN_CAP) { atomicAdd(&bar[XB_TMO], 1u); break; } }
    }
    nloc = mine > 0u ? mine : 1u; nx = cnt > 0u ? cnt : 1u;
}

__device__ __forceinline__ void xcd_barrier(const XcdBarrier& b) {
    asm volatile("s_waitcnt vmcnt(0)" ::: "memory");
    __syncthreads();
    if (threadIdx.x == 0) {
        unsigned* bar = b.bar;
        __builtin_amdgcn_s_waitcnt(0);
        unsigned nloc = b.st[0], nx = b.st[1];
        if (nloc == 0u) { xcd_barrier_complete(bar, b.x, nloc, nx); b.st[0] = nloc; b.st[1] = nx; }
        const unsigned old = xb_add(&bar[XB_XSUB(b.x)], 1u);
        const unsigned gen = old / nloc;
        if (old + 1u == (gen + 1u) * nloc) {
            __builtin_amdgcn_fence(__ATOMIC_RELEASE, "agent");
            asm volatile("s_waitcnt vmcnt(0)" ::: "memory");
            const unsigned og = xb_add(&bar[XB_TOP], 1u);
            const unsigned tg = og / nx;
            if (og + 1u == (tg + 1u) * nx) xb_add(&bar[XB_TOPGEN], 1u);
            else XB_SPIN(xb_ld(&bar[XB_TOPGEN]) == tg, bar);
            __builtin_amdgcn_fence(__ATOMIC_ACQUIRE, "agent");
            xb_add(&bar[XB_XGEN(b.x)], 1u);
            asm volatile("s_waitcnt vmcnt(0)" ::: "memory");
        } else {
            XB_SPIN(xb_ld(&bar[XB_XGEN(b.x)]) == gen, bar);
            __builtin_amdgcn_fence(__ATOMIC_ACQUIRE, "agent");
            asm volatile("s_waitcnt vmcnt(0)" ::: "memory");
        }
    }
    __syncthreads();
}
constexpr int NWAVES = 8;
constexpr int BATCH = 16, SEQ = 2048, D = 1024, FF = 2816, DEPTH = 4, M = BATCH * SEQ;
constexpr size_t MiB = 1u << 20;
constexpr size_t WS_CTL = 0, CTL_ZERO_BYTES = 4 * MiB;
constexpr int CW_BAR = 1024;
constexpr size_t WS_CS = 64 * 1024, WS_BW = 320 * 1024;
constexpr int CSV_QKV = 8 * 2 * FF;
constexpr size_t WS_IDSTAT = 640 * 1024;
constexpr size_t WS_STAT = 1 * MiB;
constexpr size_t WS_W1 = 4 * MiB;
constexpr size_t WS_W2 = WS_W1 + 88 * MiB;
constexpr size_t WS_WQKV = WS_W2 + 44 * MiB;
constexpr size_t WS_WO = WS_WQKV + 24 * MiB;
constexpr size_t WS_ZB = WS_WO + 8 * MiB;
constexpr size_t WS_QKV = WS_ZB + 64 * MiB;
constexpr size_t WS_Z16 = WS_QKV + 192 * MiB;
constexpr size_t WS_END = WS_Z16 + 64 * MiB;
constexpr int LDS_STAGE = 131072, GB_OFF = LDS_STAGE, MISC_OFF = GB_OFF + 8192, STASH_OFF = MISC_OFF + 512, LDS_BYTES = STASH_OFF + 4096;


typedef _Float16 h2_t __attribute__((ext_vector_type(2)));
__device__ __forceinline__ unsigned pk2h(float lo, float hi) { const h2_t h = (h2_t){(_Float16)lo, (_Float16)hi}; return __builtin_bit_cast(unsigned, h); }
__device__ __forceinline__ void transpose_item(const float* W, int N, bf16* WT, int Kt, int k0, int n0, int dst_row0, const float* gvec, const float* bvec, float* cs, float* bw, LAS float* scr, int lane, const bool f16out) {
    float csp[4] = {0.f, 0.f, 0.f, 0.f}, bwp[4] = {0.f, 0.f, 0.f, 0.f};
    const int c4 = lane & 7, kq = lane >> 3;
    f32x4 wv[8]; float gk[8], bk[8];
#pragma unroll
    for (int i = 0; i < 8; ++i) wv[i] = *(const f32x4*)(W + (size_t)(k0 + 8 * i + kq) * N + n0 + 4 * c4);
    if (gvec) {
#pragma unroll
        for (int i = 0; i < 8; ++i) { gk[i] = gvec[k0 + 8 * i + kq]; bk[i] = bvec[k0 + 8 * i + kq]; }
    } else {
#pragma unroll
        for (int i = 0; i < 8; ++i) { gk[i] = 1.0f; bk[i] = 0.0f; }
    }
#pragma unroll
    for (int i = 0; i < 8; ++i) { const int kk = 8 * i + kq;
#pragma unroll
        for (int j = 0; j < 4; ++j) { float wsc = wv[i][j] * gk[i]; if (f16out) wsc = __builtin_bit_cast(float, f2bf(wsc) << 16);     scr[kk * 33 + 4 * c4 + j] = wsc; csp[j] += f16out ? (float)(_Float16)wsc : __builtin_bit_cast(float, f2bf(wsc) << 16); bwp[j] += bk[i] * wv[i][j]; } }
    if (cs) {
#pragma unroll
        for (int j = 0; j < 4; ++j) { csp[j] += __shfl_xor(csp[j], 8); csp[j] += __shfl_xor(csp[j], 16); csp[j] += __shfl_xor(csp[j], 32); bwp[j] += __shfl_xor(bwp[j], 8); bwp[j] += __shfl_xor(bwp[j], 16); bwp[j] += __shfl_xor(bwp[j], 32); }
        if (lane < 8) {
#pragma unroll
            for (int j = 0; j < 4; ++j) { unsafeAtomicAdd(cs + dst_row0 + 4 * c4 + j, csp[j]); unsafeAtomicAdd(bw + dst_row0 + 4 * c4 + j, bwp[j]); } } }
    LDS_WAIT(); asm volatile("" ::: "memory");
    const int c = lane & 7;
#pragma unroll
    for (int j = 0; j < 4; ++j) { const int n = (lane >> 3) + 8 * j; const LAS float* s = scr + (8 * c) * 33 + n;
        v4u o; if (f16out) { o.x = pk2h(s[0 * 33], s[1 * 33]); o.y = pk2h(s[2 * 33], s[3 * 33]); o.z = pk2h(s[4 * 33], s[5 * 33]); o.w = pk2h(s[6 * 33], s[7 * 33]); }
        else { o.x = pk2(s[0 * 33], s[1 * 33]); o.y = pk2(s[2 * 33], s[3 * 33]); o.z = pk2(s[4 * 33], s[5 * 33]); o.w = pk2(s[6 * 33], s[7 * 33]); }
        *(v4u*)(WT + (size_t)(dst_row0 + n) * Kt + k0 + 8 * c) = o; }
    LDS_WAIT(); asm volatile("" ::: "memory");
}
__device__ __forceinline__ float wave_sum(float v) {
#pragma unroll
    for (int o = 1; o < 64; o <<= 1) v += __shfl_xor(v, o);
    return v;
}

#ifndef PROBE_GROUP
#define PROBE_GROUP 0
#endif
#define PROBE_T0(grp) unsigned long long pt0_ = 0; if (PROBE_GROUP == (grp)) pt0_ = __builtin_amdgcn_s_memrealtime();
#define PROBE_T1(grp) if (PROBE_GROUP == (grp)) { const unsigned long long pt1_ = __builtin_amdgcn_s_memrealtime(); while (__builtin_amdgcn_s_memrealtime() - pt1_ < pt1_ - pt0_) __builtin_amdgcn_s_sleep(8); }
#ifndef GEMM_F16
#define GEMM_F16 true
#endif
struct Args { const float* in[11]; float* out; unsigned char* ws; };

__global__ void __launch_bounds__(NWAVES * 64, 2) fwd_megakernel(Args args) {
    extern __shared__ __attribute__((aligned(16))) unsigned char lds_raw[];
    LAS unsigned char* lds = (LAS unsigned char*)lds_raw;
    volatile LAS unsigned* MISC = (volatile LAS unsigned*)(lds + MISC_OFF);
    const int wave = __builtin_amdgcn_readfirstlane(threadIdx.x >> 6);
    const int G = gridDim.x, bx = blockIdx.x;
    unsigned char* ws = args.ws;
    unsigned* ctl = (unsigned*)(ws + WS_CTL);
    const float* x_in = args.in[0]; const float* rel = args.in[3]; const float* ln_g = args.in[9]; const float* ln_b = args.in[10];
    float* zout = args.out;
    float* IDSTAT = (float*)(ws + WS_IDSTAT);
    float* CS = (float*)(ws + WS_CS); float* BW = (float*)(ws + WS_BW); float* STAT = (float*)(ws + WS_STAT);
    bf16* W1T = (bf16*)(ws + WS_W1); bf16* W2T = (bf16*)(ws + WS_W2); bf16* WQKVT = (bf16*)(ws + WS_WQKV); bf16* WOT = (bf16*)(ws + WS_WO);
    _Float16* Z16 = GEMM_F16 ? (_Float16*)(ws + WS_ZB) : (_Float16*)(ws + WS_Z16);
    bf16* ZB = (bf16*)(ws + WS_ZB); bf16* QB = (bf16*)(ws + WS_QKV); bf16* KB = QB + (size_t)M * D; bf16* VB = KB + (size_t)M * D; bf16* HB = QB;
    for (int u = threadIdx.x; u < (STASH_OFF - MISC_OFF) / 4; u += NWAVES * 64) ((LAS unsigned*)(lds + MISC_OFF))[u] = 0u;
    __syncthreads();
    XcdBarrier bar = xcd_barrier_post(ctl + CW_BAR, MISC + 8);

    {
        PROBE_T0(3)
        const int tid = threadIdx.x, lane = tid & 63;
        LAS float* scr = (LAS float*)(lds + wave * 16384);
        const int gw = bx * NWAVES + wave, NGW = G * NWAVES;
        constexpr int I_F = 16 * 88, N_FFN = 8 * 3 * I_F, I_QKV = 16 * 96, I_O = 16 * 32, N_MIX = 4 * (I_QKV + I_O);
        for (int it = gw; it < N_FFN + N_MIX; it += NGW) {
            if (it < N_FFN) { const int mi = it / I_F, r = it % I_F, f = mi / 3, which = mi % 3;
                if (which < 2) { const int kb = r / 88, nb = r % 88, n0 = 32 * nb, s = 3 * (f >> 1) + 2 * (f & 1);
                    const float* W = args.in[6 + which] + (size_t)f * D * FF;
                    const int dst = (n0 >> 7) * 256 + (n0 & 127) + which * 128;
                    transpose_item(W, FF, W1T + (size_t)f * 2 * FF * D, D, 64 * kb, n0, dst, s > 0 ? ln_g + (s - 1) * D : nullptr, s > 0 ? ln_b + (s - 1) * D : nullptr, CS + f * 2 * FF, BW + f * 2 * FF, scr, lane, GEMM_F16);
                } else { const int kb = r / 32, nb = r % 32;
                    transpose_item(args.in[8] + (size_t)f * FF * D, D, W2T + (size_t)f * D * FF, FF, 64 * kb, 32 * nb, 32 * nb, nullptr, nullptr, nullptr, nullptr, scr, lane, false); }
            } else { const int it2 = it - N_FFN, li = it2 / (I_QKV + I_O), r = it2 % (I_QKV + I_O), j = li >> 1, s = 3 * li + 1;
                if (r < I_QKV) { const int kb = r / 96, nb = r % 96;
                    const float* W = args.in[(li & 1) ? 4 : 1] + (size_t)j * D * 3 * D;
                    transpose_item(W, 3 * D, WQKVT + (size_t)li * 3 * D * D, D, 64 * kb, 32 * nb, 32 * nb, ln_g + (s - 1) * D, ln_b + (s - 1) * D, CS + CSV_QKV + li * 3 * D, BW + CSV_QKV + li * 3 * D, scr, lane, GEMM_F16);
                } else { const int r2 = r - I_QKV, kb = r2 / 32, nb = r2 % 32;
                    const float* W = args.in[(li & 1) ? 5 : 2] + (size_t)j * D * D;
                    transpose_item(W, D, WOT + (size_t)li * D * D, D, 64 * kb, 32 * nb, 32 * nb, nullptr, nullptr, nullptr, nullptr, scr, lane, false); }
            }
        }
        for (int r = bx * (NWAVES * 64) + tid; r < M; r += G * NWAVES * 64) { IDSTAT[2 * r] = 0.0f; IDSTAT[2 * r + 1] = 1024.0f * (1.0f - 1e-5f); }
        const size_t nch = (size_t)M * D / 8, nthr = (size_t)G * NWAVES * 64;
        size_t c = (size_t)bx * (NWAVES * 64) + tid;
        for (; c + 3 * nthr < nch; c += 4 * nthr) {
            f32x4 a[4], b[4];
#pragma unroll
            for (int j = 0; j < 4; ++j) { a[j] = *(const f32x4*)(x_in + (c + j * nthr) * 8); b[j] = *(const f32x4*)(x_in + (c + j * nthr) * 8 + 4); }
#pragma unroll
            for (int j = 0; j < 4; ++j) { v4u o; o.x = pk2h(a[j][0], a[j][1]); o.y = pk2h(a[j][2], a[j][3]); o.z = pk2h(b[j][0], b[j][1]); o.w = pk2h(b[j][2], b[j][3]); *(v4u*)(ZB + (c + j * nthr) * 8) = o; } }
        for (; c < nch; c += nthr) { const f32x4 a = *(const f32x4*)(x_in + c * 8), b = *(const f32x4*)(x_in + c * 8 + 4);
            v4u o; o.x = pk2h(a[0], a[1]); o.y = pk2h(a[2], a[3]); o.z = pk2h(b[0], b[1]); o.w = pk2h(b[2], b[3]); *(v4u*)(ZB + c * 8) = o; }
        PROBE_T1(3)
    }
    __syncthreads();
    cg::this_grid().sync();

#define GRID_BAR() do { PROBE_T0(4) xcd_barrier(bar); PROBE_T1(4) } while (0)
#define GRID_BAR_C(cls) do { PROBE_T0(cls) xcd_barrier(bar); PROBE_T1(cls) } while (0)
#pragma unroll 1
    for (int li_ = 0; li_ < DEPTH; ++li_) {
#pragma unroll 1
        for (int sub_ = 0; sub_ < 3; ++sub_) {
            int li = li_, sub = sub_; asm volatile("" : "+s"(li), "+s"(sub)); unsigned zv_; asm volatile("v_mov_b32 %0, 0" : "=v"(zv_)); int tidv = wave * 64 + (int)__builtin_amdgcn_mbcnt_hi(~0u, __builtin_amdgcn_mbcnt_lo(~0u, zv_)); asm volatile("" : "+v"(tidv));
            const int s = 3 * li + sub;
            const float* stat_in = s > 0 ? STAT + (size_t)(s - 1) * M * 2 : IDSTAT;
            float* stat_out = STAT + (size_t)s * M * 2;
            const float* gin = ln_g + (s > 0 ? s - 1 : 0) * D; const float* bin = ln_b + (s > 0 ? s - 1 : 0) * D;
            { LAS float* gbw = (LAS float*)(lds + GB_OFF); for (int c = tidv; c < D; c += NWAVES * 64) { gbw[c] = s > 0 ? gin[c] : 1.0f; gbw[D + c] = s > 0 ? bin[c] : 0.0f; } }
            __syncthreads();
            if (sub != 1) {
                const int f = 2 * li + (sub >> 1);
                { PROBE_T0(1) pg8::Gemm g{ZB, W1T + (size_t)f * 2 * FF * D, M, 2 * FF, D}; pg8::StaticOrder S; S.init(M, 2 * FF, G, bx);
                  pg8::EpiSwiglu E{HB, stat_in, CS + f * 2 * FF, BW + f * 2 * FF, (LAS float*)(lds + STASH_OFF)};
                  asm volatile("" : "+v"(tidv)); pg8::gemm_phase<pg8::EpiSwiglu, pg8::StaticOrder, true, true, GEMM_F16>(lds, tidv, g, S, E); PROBE_T1(1) }
                GRID_BAR_C(11);
                { PROBE_T0(1) pg8::Gemm g{HB, W2T + (size_t)f * D * FF, M, D, FF}; pg8::StaticOrder S; S.init(M, D, G, bx, 1);
                  pg8::EpiResid E{Z16, stat_in, (const LAS float*)(lds + GB_OFF), stat_out, 0.5f};
                  asm volatile("" : "+v"(tidv)); pg8::gemm_phase<pg8::EpiResid, pg8::StaticOrder, true, true>(lds, tidv, g, S, E); PROBE_T1(1) }
                GRID_BAR_C(12);
            } else {
                { PROBE_T0(1) pg8::Gemm g{ZB, WQKVT + (size_t)li * 3 * D * D, M, 3 * D, D}; pg8::StaticOrder S; S.init(M, 3 * D, G, bx);
                  pg8::EpiQKV E{QB, (size_t)M * D, stat_in, CS + CSV_QKV + li * 3 * D, BW + CSV_QKV + li * 3 * D, 0.125f * 1.4426950408889634f, (LAS float*)(lds + STASH_OFF)};
                  asm volatile("" : "+v"(tidv)); pg8::gemm_phase<pg8::EpiQKV, pg8::StaticOrder, true, true, GEMM_F16>(lds, tidv, g, S, E); PROBE_T1(1) }
                GRID_BAR_C(13);
                asm volatile("" : "+v"(tidv));
                { PROBE_T0(2)
                for (int vb = bx; vb < 256; vb += G) { const int grp = vb >> 1, e = vb & 1, b = grp >> 3, hp = grp & 7;
                    att::bf16x8 qn[4]; att::Stage Sn;
                    if ((li & 1) == 0) { att::chunk_prefetch(b, hp, e ^ 1, QB, KB, VB, qn, Sn, tidv);
                        for (int i = 0; i < 8; ++i) { asm volatile("" : "+v"(tidv)); att::chunk_attn_unit(b, hp, i == 0 ? (e ^ 1) : 2 * i + e, i < 7 ? 2 * (i + 1) + e : -1, qn, Sn, QB, KB, VB, QB, rel, lds, tidv); } }
                    else { att::stick_prefetch(b, hp, e, QB, KB, VB, qn, Sn, tidv);
                        for (int i = 0; i < 8; ++i) { const int k = 2 * (i >> 1) + e, qb = (i & 1) ? 15 - k : k, i1 = i + 1, k1 = 2 * (i1 >> 1) + e, qb1 = i1 < 8 ? ((i1 & 1) ? 15 - k1 : k1) : -1;
                            asm volatile("" : "+v"(tidv)); att::stick_attn_unit(b, hp, qb, qb1, qn, Sn, QB, KB, VB, QB, lds, tidv); } } }
                PROBE_T1(2) }
                GRID_BAR_C(14);
                { PROBE_T0(1) pg8::Gemm g{QB, WOT + (size_t)li * D * D, M, D, D}; pg8::StaticOrder S; S.init(M, D, G, bx);
                  pg8::EpiResid E{Z16, stat_in, (const LAS float*)(lds + GB_OFF), stat_out, 1.0f};
                  asm volatile("" : "+v"(tidv)); pg8::gemm_phase<pg8::EpiResid, pg8::StaticOrder, true, true>(lds, tidv, g, S, E); PROBE_T1(1) }
                GRID_BAR_C(15);
            }
        }
    }
    {
        PROBE_T0(5)
        unsigned zv2_; asm volatile("v_mov_b32 %0, 0" : "=v"(zv2_)); const int lane = (int)__builtin_amdgcn_mbcnt_hi(~0u, __builtin_amdgcn_mbcnt_lo(~0u, zv2_));
        const int gw = bx * NWAVES + wave, NGW = G * NWAVES; const float* gl = ln_g + 11 * D; const float* bl = ln_b + 11 * D;
        f32x4 ggv[4], bbv[4];
#pragma unroll
        for (int j = 0; j < 4; ++j) { const int c4 = 2 * lane + (j & 1) + 128 * (j >> 1); ggv[j] = *((const f32x4*)gl + c4); bbv[j] = *((const f32x4*)bl + c4); }
        auto ln_rows = [&](const int m0, const int nr) __attribute__((always_inline)) {
            pg8::f16x8 h[2][2];
#pragma unroll
            for (int r = 0; r < 2; ++r) if (r < nr) { const pg8::f16x8* zr16 = (const pg8::f16x8*)(Z16 + (size_t)(m0 + r * NGW) * D) + lane;
                h[r][0] = zr16[0]; h[r][1] = zr16[64]; }
#pragma unroll
            for (int r = 0; r < 2; ++r) if (r < nr) { const int m = m0 + r * NGW; f32x4 v[4]; float s = 0.f;
#pragma unroll
                for (int jj = 0; jj < 2; ++jj) { v[2 * jj] = (f32x4){(float)h[r][jj][0], (float)h[r][jj][1], (float)h[r][jj][2], (float)h[r][jj][3]}; v[2 * jj + 1] = (f32x4){(float)h[r][jj][4], (float)h[r][jj][5], (float)h[r][jj][6], (float)h[r][jj][7]}; }
#pragma unroll
                for (int j = 0; j < 4; ++j) s += (v[j][0] + v[j][1]) + (v[j][2] + v[j][3]);
                const float mean = wave_sum(s) * (1.f / D); float s2 = 0.f;
#pragma unroll
                for (int j = 0; j < 4; ++j) { v[j] = v[j] - mean; s2 += (v[j][0] * v[j][0] + v[j][1] * v[j][1]) + (v[j][2] * v[j][2] + v[j][3] * v[j][3]); }
                const float rstd = 1.f / sqrtf(wave_sum(s2) * (1.f / D) + 1e-5f);
#pragma unroll
                for (int j = 0; j < 4; ++j) { const int c4 = 2 * lane + (j & 1) + 128 * (j >> 1);
                    *((f32x4*)(zout + (size_t)m * D) + c4) = v[j] * rstd * ggv[j] + bbv[j]; } }
        };
        int m = gw;
        for (; m + NGW < M; m += 2 * NGW) ln_rows(m, 2);
        if (m < M) ln_rows(m, 1);
        PROBE_T1(5)
    }
}

extern "C" void kernel_launch(void* const* d_in, const int* in_sizes, int n_in, void* d_out, int out_size, void* d_ws, size_t ws_size, hipStream_t stream) {
    static int grid = 0;
    if (grid == 0) {
        if (n_in != 11 || ws_size < WS_END) { fprintf(stderr, "kernel_launch: unexpected inputs (n_in %d, ws %zu)\n", n_in, ws_size); grid = -1; return; }
        int dev = 0, cus = 0, per_cu = 0;
        (void)hipGetDevice(&dev); (void)hipDeviceGetAttribute(&cus, hipDeviceAttributeMultiprocessorCount, dev);
        (void)hipFuncSetAttribute((const void*)fwd_megakernel, hipFuncAttributeMaxDynamicSharedMemorySize, LDS_BYTES);
        if (hipOccupancyMaxActiveBlocksPerMultiprocessor(&per_cu, (const void*)fwd_megakernel, NWAVES * 64, LDS_BYTES) != hipSuccess || per_cu < 1) { fprintf(stderr, "kernel_launch: occupancy query says %d\n", per_cu); per_cu = 1; }
        (void)hipGetLastError();
        grid = cus;
        if (grid > 256) grid = 256;
    }
    if (grid < 0) return;
    (void)hipMemsetAsync((char*)d_ws + WS_CTL, 0, CTL_ZERO_BYTES, stream);
    Args a{};
    for (int i = 0; i < 11; ++i) a.in[i] = (const float*)d_in[i];
    a.out = (float*)d_out; a.ws = (unsigned char*)d_ws;
    void* kargs[] = {&a};
    hipError_t e = hipLaunchCooperativeKernel((const void*)fwd_megakernel, dim3(grid), dim3(NWAVES * 64), kargs, LDS_BYTES, stream);
    if (e != hipSuccess) fprintf(stderr, "cooperative launch failed: %s (grid %d)\n", hipGetErrorString(e), grid);
}
```
